# Optimizing an MI355X kernel written in HIP

```python
import math
import jax, jax.numpy as jnp
from jax import lax
import numpy as np

D_MODEL = 2048
BATCH = 32
SEQ = 256
DEPTH = 2
DEC_BATCH = 8
DEC_SEQ = 4096
PAST_LEN = 512

GRID_W = 64
N_EVEN = (DEPTH + 1) // 2
N_ODD = DEPTH // 2
EPS = 1e-6
ATTN_QBLK = 128
ROPE_BASE = 10000.0
A_HEADS = 8
A_QK_DIM = 64
A_V_DIM = 128
A_WIDTH = A_HEADS * A_V_DIM
LRU_WIDTH = 1024
LRU_BLOCKS = 8
LRU_BLOCK = LRU_WIDTH // LRU_BLOCKS
CONV_W = 4
LRU_C = 8.0
EVEN_IN = 3 * A_WIDTH + 2 * LRU_WIDTH
EVEN_SPLITS = (A_WIDTH, 2 * A_WIDTH, 3 * A_WIDTH, 3 * A_WIDTH + LRU_WIDTH)
C_HEADS = 16
C_HEAD_DIM = 128
C_WIDTH = C_HEADS * C_HEAD_DIM
NA_KH = 8
NA_KW = 16
NA_QBLK = 16
NA_BAND = 32
PEER_HEADS = 8
PEER_NKEYS = 128
PEER_N = PEER_NKEYS * PEER_NKEYS
PEER_QDIM = 256
PEER_TOPK = 16
PEER_CHUNK = 128

kernel_name = 'peer_hybrid_diffusion_step'


def rmsnorm(x, g):
    xf = x.astype(jnp.float32)
    y = xf * lax.rsqrt(jnp.mean(xf * xf, axis=-1, keepdims=True) + EPS)
    return (y * g.astype(jnp.float32)).astype(x.dtype)


def modulation(cond, w_mod, b_mod):
    m = jax.nn.silu(cond) @ w_mod + b_mod
    return jnp.split(m[..., None, :], 6, axis=-1)


def pre(x, g, shift, scale):
    return rmsnorm(x, g) * (1.0 + scale) + shift


def axial_rope_tables(T):
    t = jnp.arange(T)
    row = (t // GRID_W).astype(jnp.float32)
    col = (t % GRID_W).astype(jnp.float32)
    n_freq = A_QK_DIM // 4
    inv = ROPE_BASE ** (-jnp.arange(n_freq, dtype=jnp.float32) / n_freq)
    ang = jnp.stack([row[:, None] * inv, col[:, None] * inv], axis=1)
    return jnp.cos(ang), jnp.sin(ang)


def apply_axial_rope(x, cos, sin):
    shp = x.shape
    xr = x.reshape(shp[:-1] + (2, 2, A_QK_DIM // 4))
    x1, x2 = xr[..., 0, :], xr[..., 1, :]
    c = cos[None, :, None, None].astype(x.dtype)
    s = sin[None, :, None, None].astype(x.dtype)
    out = jnp.stack([x1 * c - x2 * s, x2 * c + x1 * s], axis=-2)
    return out.reshape(shp)


def _query_blocks(q):
    B, T = q.shape[:2]
    nb = T // ATTN_QBLK
    return q.reshape((B, nb, ATTN_QBLK) + q.shape[2:]).swapaxes(0, 1)


def _merge_blocks(o):
    nb, B, qb = o.shape[:3]
    return o.swapaxes(0, 1).reshape((B, nb * qb) + o.shape[3:])


def diff_lambda(lam_p, lam_init):
    lp = lam_p.astype(jnp.float32)
    return jnp.exp(jnp.sum(lp[0] * lp[1])) - jnp.exp(jnp.sum(lp[2] * lp[3])) + lam_init


def diff_attention(q, k, v, lam):
    scale = A_QK_DIM ** -0.5

    def block(qi):
        s = jnp.einsum('bqhmd,bkhmd->bhmqk', qi, k).astype(jnp.float32) * scale
        p = jax.nn.softmax(s, axis=-1)
        w = p[:, :, 0] - lam * p[:, :, 1]
        return jnp.einsum('bhqk,bkhe->bqhe', w.astype(v.dtype), v)

    return _merge_blocks(lax.map(block, _query_blocks(q)))


def attention(q, k, v):
    scale = q.shape[-1] ** -0.5

    def block(qi):
        s = jnp.einsum('bqhd,bkhd->bhqk', qi, k).astype(jnp.float32) * scale
        p = jax.nn.softmax(s, axis=-1)
        return jnp.einsum('bhqk,bkhd->bqhd', p.astype(v.dtype), v)

    return _merge_blocks(lax.map(block, _query_blocks(q)))


def neighbourhood_attention(q, k, v, ck, cv, rpb):
    B, T, H, d = q.shape
    rows = T // GRID_W
    kh = min(NA_KH, rows)
    ncb = GRID_W // NA_QBLK
    qcol = np.arange(GRID_W).reshape(ncb, NA_QBLK)
    band0 = np.clip(np.arange(ncb) * NA_QBLK - NA_KW // 2, 0, GRID_W - NA_BAND)
    band_cols = band0[:, None] + np.arange(NA_BAND)[None, :]
    cs = np.clip(qcol - NA_KW // 2, 0, GRID_W - NA_KW)
    col_ok = (band_cols[:, None, :] >= cs[..., None]) & (band_cols[:, None, :] < cs[..., None] + NA_KW)
    col_off = np.clip(band_cols[:, None, :] - qcol[..., None] + NA_KW - 1, 0, 2 * NA_KW - 2)
    kg = k.reshape(B, rows, GRID_W, H, d)
    vg = v.reshape(B, rows, GRID_W, H, d)
    qg = q.reshape(B, rows, ncb, NA_QBLK, H, d)
    scale = d ** -0.5
    n_lat = kh * NA_BAND

    def row_fn(r):
        rs = jnp.clip(r - kh // 2, 0, rows - kh)
        qr = lax.dynamic_index_in_dim(qg, r, axis=1, keepdims=False)
        kb = lax.dynamic_slice_in_dim(kg, rs, kh, axis=1)[:, :, band_cols]
        vb = lax.dynamic_slice_in_dim(vg, rs, kh, axis=1)[:, :, band_cols]
        row_idx = rs + jnp.arange(kh) - r + (NA_KH - 1)
        bias = rpb[:, row_idx[None, None, :, None], col_off[:, :, None, :]]
        s_lat = jnp.einsum('bjqhd,bijkhd->bhjqik', qr, kb).astype(jnp.float32) * scale
        s_lat = s_lat + bias.astype(jnp.float32)[None]
        s_lat = jnp.where(col_ok[:, :, None, :], s_lat, -jnp.inf)
        s_ctx = jnp.einsum('bjqhd,bkhd->bhjqk', qr, ck).astype(jnp.float32) * scale
        s = jnp.concatenate([s_lat.reshape(B, H, ncb, NA_QBLK, n_lat), s_ctx], axis=-1)
        p = jax.nn.softmax(s, axis=-1).astype(v.dtype)
        p_lat = p[..., :n_lat].reshape(B, H, ncb, NA_QBLK, kh, NA_BAND)
        o = (jnp.einsum('bhjqik,bijkhd->bjqhd', p_lat, vb)
             + jnp.einsum('bhjqk,bkhd->bjqhd', p[..., n_lat:], cv))
        return o.reshape(B, GRID_W, H * d)

    o = lax.map(row_fn, jnp.arange(rows))
    return o.transpose(1, 0, 2, 3).reshape(B, T, H * d)


def centred_conv(x, w, b):
    T = x.shape[1]
    left = CONV_W // 2
    xp = jnp.pad(x, ((0, 0), (left, CONV_W - 1 - left), (0, 0)))
    y = xp[:, 0:T] * w[0]
    for j in range(1, CONV_W):
        y = y + xp[:, j:j + T] * w[j]
    return y + b


def block_diag(x, w, b):
    xb = x.reshape(x.shape[:-1] + (LRU_BLOCKS, LRU_BLOCK))
    return jnp.einsum('btni,nio->btno', xb, w).reshape(x.shape) + b


def rglru_direction(xc, h0, w_a, b_a, w_i, b_i, lam, reverse):
    r = jax.nn.sigmoid(block_diag(xc, w_a, b_a).astype(jnp.float32))
    i = jax.nn.sigmoid(block_diag(xc, w_i, b_i).astype(jnp.float32))
    log_a = -LRU_C * r * jax.nn.softplus(-lam.astype(jnp.float32))
    a = jnp.exp(log_a)
    bt = jnp.sqrt(-jnp.expm1(2.0 * log_a)) * i * xc.astype(jnp.float32)
    edge = -1 if reverse else 0
    bt = bt.at[:, edge].add(a[:, edge] * h0.astype(jnp.float32))

    def comb(e1, e2):
        a1, b1 = e1
        a2, b2 = e2
        return a1 * a2, a2 * b1 + b2

    _, h = lax.associative_scan(comb, (a, bt), reverse=reverse, axis=1)
    return h


def lru_mixer(xr, g, h0, conv_w, conv_b, w_a, b_a, w_i, b_i, lam):
    xc = centred_conv(xr, conv_w, conv_b)
    hf = rglru_direction(xc, h0[:, 0], w_a[0], b_a[0], w_i[0], b_i[0], lam[0], False)
    hb = rglru_direction(xc, h0[:, 1], w_a[1], b_a[1], w_i[1], b_i[1], lam[1], True)
    out = (hf + hb).astype(xr.dtype) * jax.nn.gelu(g)
    fin = jnp.stack([hf[:, -1], hb[:, 0]], axis=1).astype(xr.dtype)
    return out, fin


def even_mixer(xm, ctx, w_in, w_out, lam_p, subln_g, lam_init,
               conv_w, conv_b, w_a, b_a, w_i, b_i, lru_lam):
    B, T, _ = xm.shape
    q, k, v, xr, g = jnp.split(xm @ w_in, EVEN_SPLITS, axis=-1)
    q = q.reshape(B, T, A_HEADS, 2, A_QK_DIM)
    k = k.reshape(B, T, A_HEADS, 2, A_QK_DIM)
    v = v.reshape(B, T, A_HEADS, A_V_DIM)
    lam = diff_lambda(lam_p, lam_init)
    if ctx is None:
        kk, vv = k, v
        h0 = jnp.zeros((B, 2, LRU_WIDTH), xm.dtype)
    else:
        ck, cv, h0 = ctx
        cos, sin = axial_rope_tables(T)
        q = apply_axial_rope(q, cos, sin)
        k = apply_axial_rope(k, cos, sin)
        kk = jnp.concatenate([ck.reshape(B, -1, A_HEADS, 2, A_QK_DIM), k], axis=1)
        vv = jnp.concatenate([cv, v], axis=1)
    o_a = rmsnorm(diff_attention(q, kk, vv, lam), subln_g) * (1.0 - lam_init)
    o_b, fin = lru_mixer(xr, g, h0, conv_w, conv_b, w_a, b_a, w_i, b_i, lru_lam)
    out = jnp.concatenate([o_a.reshape(B, T, A_WIDTH), o_b], axis=-1) @ w_out
    return out, k.reshape(B, T, A_HEADS, 2 * A_QK_DIM), v, fin


def odd_mixer(xm, ctx, w_in, w_out, rpb):
    B, T, _ = xm.shape
    q, k, v = jnp.split(xm @ w_in, 3, axis=-1)
    q = q.reshape(B, T, C_HEADS, C_HEAD_DIM)
    k = k.reshape(B, T, C_HEADS, C_HEAD_DIM)
    v = v.reshape(B, T, C_HEADS, C_HEAD_DIM)
    if ctx is None:
        o = attention(q, k, v)
    else:
        o = neighbourhood_attention(q, k, v, ctx[0], ctx[1], rpb)
    return o.reshape(B, T, C_WIDTH) @ w_out, k, v


def peer(x, w_q, sub_keys, u_tab, v_tab):
    B, T, D = x.shape
    n = B * T
    xf = x.reshape(n, D)
    q = (xf @ w_q).reshape(n, PEER_HEADS, 2, PEER_QDIM // 2)
    s = jnp.einsum('nhpd,hpkd->nhpk', q, sub_keys).astype(jnp.float32)
    top_s, top_i = lax.top_k(s, PEER_TOPK)
    cand = top_s[:, :, 0, :, None] + top_s[:, :, 1, None, :]
    best_s, best_p = lax.top_k(cand.reshape(n, PEER_HEADS, PEER_TOPK * PEER_TOPK), PEER_TOPK)
    i1 = jnp.take_along_axis(top_i[:, :, 0], best_p // PEER_TOPK, axis=-1)
    i2 = jnp.take_along_axis(top_i[:, :, 1], best_p % PEER_TOPK, axis=-1)
    idx = i1 * PEER_NKEYS + i2
    gates = jax.nn.softmax(best_s, axis=-1).astype(x.dtype)
    nc = n // PEER_CHUNK

    def chunk(args):
        xc, ic, gc = args
        act = jax.nn.gelu(jnp.einsum('cd,chkd->chk', xc, u_tab[ic])) * gc
        return jnp.einsum('chk,chkd->cd', act, v_tab[ic])

    out = lax.map(chunk, (xf.reshape(nc, PEER_CHUNK, D),
                          idx.reshape(nc, PEER_CHUNK, PEER_HEADS, PEER_TOPK),
                          gates.reshape(nc, PEER_CHUNK, PEER_HEADS, PEER_TOPK)))
    return out.reshape(B, T, D)


def setup_inputs(seed: int = 0) -> dict:
    key = jax.random.key(seed)
    ks = iter(jax.random.split(key, 40))
    f32 = jnp.float32

    def nrm(shape, scale=1.0):
        return jax.random.normal(next(ks), shape, f32) * scale

    def gain(shape):
        return 1.0 + nrm(shape, 0.02)

    u = jax.random.uniform(next(ks), (N_EVEN, 2, LRU_WIDTH), f32, minval=0.9, maxval=0.999)
    a_base = u ** (1.0 / LRU_C)
    return {
        'x_prompt': nrm((BATCH, SEQ, D_MODEL)),
        'x_sample': nrm((DEC_BATCH, DEC_SEQ, D_MODEL)),
        'cache_a_k': nrm((DEC_BATCH, N_EVEN, PAST_LEN, A_HEADS, 2 * A_QK_DIM)),
        'cache_a_v': nrm((DEC_BATCH, N_EVEN, PAST_LEN, A_HEADS, A_V_DIM)),
        'state_lru': nrm((DEC_BATCH, N_EVEN, 2, LRU_WIDTH), 0.5),
        'cache_c_k': nrm((DEC_BATCH, N_ODD, PAST_LEN, C_HEADS, C_HEAD_DIM)),
        'cache_c_v': nrm((DEC_BATCH, N_ODD, PAST_LEN, C_HEADS, C_HEAD_DIM)),
        'c': nrm((DEC_BATCH, D_MODEL)),
        'c_ctx': nrm((D_MODEL,)),
        'w_mod': nrm((DEPTH, D_MODEL, 6 * D_MODEL), 0.5 * D_MODEL ** -0.5),
        'b_mod': nrm((DEPTH, 6 * D_MODEL), 0.02),
        'norm1_g': gain((DEPTH, D_MODEL)),
        'norm2_g': gain((DEPTH, D_MODEL)),
        'final_norm_g': gain((D_MODEL,)),
        'even_w_in': nrm((N_EVEN, D_MODEL, EVEN_IN), D_MODEL ** -0.5),
        'even_w_out': nrm((N_EVEN, A_WIDTH + LRU_WIDTH, D_MODEL), (A_WIDTH + LRU_WIDTH) ** -0.5),
        'a_lambda': nrm((N_EVEN, 4, A_QK_DIM), 0.1),
        'a_subln_g': gain((N_EVEN, A_V_DIM)),
        'lru_conv_w': nrm((N_EVEN, CONV_W, LRU_WIDTH), CONV_W ** -0.5),
        'lru_conv_b': nrm((N_EVEN, LRU_WIDTH), 0.02),
        'lru_w_a': nrm((N_EVEN, 2, LRU_BLOCKS, LRU_BLOCK, LRU_BLOCK), LRU_BLOCK ** -0.5),
        'lru_b_a': nrm((N_EVEN, 2, LRU_WIDTH), 0.02),
        'lru_w_i': nrm((N_EVEN, 2, LRU_BLOCKS, LRU_BLOCK, LRU_BLOCK), LRU_BLOCK ** -0.5),
        'lru_b_i': nrm((N_EVEN, 2, LRU_WIDTH), 0.02),
        'lru_lambda': jnp.log(a_base) - jnp.log1p(-a_base),
        'odd_w_in': nrm((N_ODD, D_MODEL, 3 * C_WIDTH), D_MODEL ** -0.5),
        'odd_w_out': nrm((N_ODD, C_WIDTH, D_MODEL), C_WIDTH ** -0.5),
        'na_rpb': nrm((N_ODD, C_HEADS, 2 * NA_KH - 1, 2 * NA_KW - 1), 0.1),
        'peer_w_q': nrm((DEPTH, D_MODEL, PEER_HEADS * PEER_QDIM), D_MODEL ** -0.5),
        'peer_sub_keys': nrm((DEPTH, PEER_HEADS, 2, PEER_NKEYS, PEER_QDIM // 2), (PEER_QDIM // 2) ** -0.5),
        'peer_u': nrm((DEPTH, PEER_N, D_MODEL), D_MODEL ** -0.5),
        'peer_v': nrm((DEPTH, PEER_N, D_MODEL), 0.05),
    }


def reference(x_prompt, x_sample, cache_a_k, cache_a_v, state_lru, cache_c_k, cache_c_v,
              c, c_ctx, w_mod, b_mod, norm1_g, norm2_g, final_norm_g,
              even_w_in, even_w_out, a_lambda, a_subln_g, lru_conv_w, lru_conv_b,
              lru_w_a, lru_b_a, lru_w_i, lru_b_i, lru_lambda,
              odd_w_in, odd_w_out, na_rpb, peer_w_q, peer_sub_keys, peer_u, peer_v):
    xp, xs = x_prompt, x_sample
    new_ak, new_av, new_lru, new_ck, new_cv = [], [], [], [], []
    for l in range(DEPTH):
        mc = modulation(c_ctx, w_mod[l], b_mod[l])
        ms = modulation(c, w_mod[l], b_mod[l])
        hp = pre(xp, norm1_g[l], mc[0], mc[1])
        hs = pre(xs, norm1_g[l], ms[0], ms[1])
        if l % 2 == 0:
            e = l // 2
            lam_init = 0.8 - 0.6 * math.exp(-0.3 * l)
            lp = (even_w_in[e], even_w_out[e], a_lambda[e], a_subln_g[e], lam_init,
                  lru_conv_w[e], lru_conv_b[e], lru_w_a[e], lru_b_a[e], lru_w_i[e],
                  lru_b_i[e], lru_lambda[e])
            op, kp, vp, sp = even_mixer(hp, None, *lp)
            os_, _, _, _ = even_mixer(hs, (cache_a_k[:, e], cache_a_v[:, e], state_lru[:, e]), *lp)
            new_ak.append(kp)
            new_av.append(vp)
            new_lru.append(sp)
        else:
            o = l // 2
            op, kp, vp = odd_mixer(hp, None, odd_w_in[o], odd_w_out[o], na_rpb[o])
            os_, _, _ = odd_mixer(hs, (cache_c_k[:, o], cache_c_v[:, o]),
                                  odd_w_in[o], odd_w_out[o], na_rpb[o])
            new_ck.append(kp)
            new_cv.append(vp)
        xp = xp + mc[2] * op
        xs = xs + ms[2] * os_
        hp = pre(xp, norm2_g[l], mc[3], mc[4])
        hs = pre(xs, norm2_g[l], ms[3], ms[4])
        xp = xp + mc[5] * peer(hp, peer_w_q[l], peer_sub_keys[l], peer_u[l], peer_v[l])
        xs = xs + ms[5] * peer(hs, peer_w_q[l], peer_sub_keys[l], peer_u[l], peer_v[l])
    y_prompt = rmsnorm(xp, final_norm_g)
    y_sample = rmsnorm(xs, final_norm_g)
    return (y_prompt, y_sample, jnp.stack(new_ak, axis=1), jnp.stack(new_av, axis=1),
            jnp.stack(new_lru, axis=1), jnp.stack(new_ck, axis=1), jnp.stack(new_cv, axis=1))
```

```cpp
#include <hip/hip_runtime.h>
#include <stdint.h>
#include <stdio.h>

#define LAS __attribute__((address_space(3)))
typedef unsigned short bf16_t;
typedef short bf16x8 __attribute__((ext_vector_type(8)));
typedef short s16x4 __attribute__((ext_vector_type(4)));
typedef float f32x2 __attribute__((ext_vector_type(2)));
typedef float f32x4 __attribute__((ext_vector_type(4)));
typedef float f32x16 __attribute__((ext_vector_type(16)));
typedef unsigned u32x2 __attribute__((ext_vector_type(2)));
typedef unsigned u32x4 __attribute__((ext_vector_type(4)));
#define DI __device__ __forceinline__

constexpr int D = 2048, NP = 8192  , NS = 32768  , NTOK = NP + NS;
constexpr int TP = 256, TS = 4096, PAST = 512;
constexpr int EVEN_IN = 5120, ODD_IN = 6144;
constexpr int PEER_N = 16384;
constexpr int NWAVES = 8, NTHR = 512;
constexpr int LDS_BYTES = 147456;
constexpr int LDS_MISC = LDS_BYTES - 256;

constexpr size_t OUT_YP = 0, OUT_YS = OUT_YP + (size_t)NP * D, OUT_AK = OUT_YS + (size_t)NS * D, OUT_AV = OUT_AK + (size_t)NP * 1024,
                 OUT_LRU = OUT_AV + (size_t)NP * 1024, OUT_CK = OUT_LRU + 32 * 2 * 1024, OUT_CV = OUT_CK + (size_t)NP * 2048, OUT_END = OUT_CV + (size_t)NP * 2048;

constexpr size_t al256(size_t x) { return (x + 255) & ~(size_t)255; }
constexpr size_t WS_BAR = 0;
constexpr size_t WS_CTR = 16384;
constexpr size_t WS_ZERO_BYTES = 20480;
constexpr size_t WS_SCAL = WS_ZERO_BYTES;
constexpr size_t WS_ROPE = WS_SCAL + 256;
constexpr size_t WS_MOD = al256(WS_ROPE + 64 * 16 * 2 * 4);
constexpr size_t WS_WEI = al256(WS_MOD + (size_t)2 * 9 * 12288 * 4);
constexpr size_t WS_WEO = WS_WEI + (size_t)EVEN_IN * D * 2;
constexpr size_t WS_WOI = WS_WEO + (size_t)D * D * 2;
constexpr size_t WS_WOO = WS_WOI + (size_t)ODD_IN * D * 2;
constexpr size_t WS_WPQ = WS_WOO + (size_t)D * D * 2;
constexpr size_t WS_SK = WS_WPQ + (size_t)2 * D * D * 2;
constexpr size_t WS_LRW = WS_SK + (size_t)2 * 8 * 2 * 128 * 128 * 2;
constexpr size_t WS_CAK = WS_LRW + (size_t)2 * 2 * 8 * 128 * 128 * 2;
constexpr size_t WS_CAV = WS_CAK + (size_t)8 * 512 * 1024 * 2;
constexpr size_t WS_CCK = WS_CAV + (size_t)8 * 512 * 1024 * 2;
constexpr size_t WS_CCV = WS_CCK + (size_t)8 * 512 * 2048 * 2;
constexpr size_t WS_PU = WS_CCV + (size_t)8 * 512 * 2048 * 2;
constexpr size_t WS_PV = WS_PU + (size_t)2 * PEER_N * D * 2;
constexpr size_t WS_H = WS_PV + (size_t)2 * PEER_N * D * 2;
constexpr size_t WS_PROJ = WS_H + (size_t)NTOK * D * 2;
constexpr size_t WS_MIX = WS_PROJ + (size_t)NTOK * ODD_IN * 2;
constexpr size_t WS_PIDX = WS_MIX + (size_t)NTOK * D * 2;
constexpr size_t WS_PGATE = WS_PIDX + (size_t)NTOK * 128 * 4;
constexpr size_t WS_END = WS_PGATE + (size_t)NTOK * 128 * 4;

struct Params {
    const float *x_prompt, *x_sample, *cache_a_k, *cache_a_v, *state_lru, *cache_c_k, *cache_c_v, *c, *c_ctx, *w_mod, *b_mod, *norm1_g, *norm2_g, *final_norm_g,
        *even_w_in, *even_w_out, *a_lambda, *a_subln_g, *lru_conv_w, *lru_conv_b, *lru_w_a, *lru_b_a, *lru_w_i, *lru_b_i, *lru_lambda,
        *odd_w_in, *odd_w_out, *na_rpb, *peer_w_q, *peer_sub_keys, *peer_u, *peer_v;
    float* out; unsigned char* ws; int ph_lo, ph_hi;
};

DI unsigned cvt_pk_bf16(float lo, float hi) { unsigned r; asm volatile("v_cvt_pk_bf16_f32 %0, %1, %2" : "=v"(r) : "v"(lo), "v"(hi)); return r; }
DI float bf_lo(unsigned u) { return __uint_as_float(u << 16); }
DI float bf_hi(unsigned u) { return __uint_as_float(u & 0xffff0000u); }
DI float wave_sum(float v) { v += __shfl_xor(v, 1); v += __shfl_xor(v, 2); v += __shfl_xor(v, 4); v += __shfl_xor(v, 8); v += __shfl_xor(v, 16); v += __shfl_xor(v, 32); return v; }
DI int cond_of_row(int row) { return row < NP ? 0 : 1 + ((row - NP) >> 12); }
DI float gelu_tanh(float x) { const float u = 0.7978845608028654f * (x + 0.044715f * x * x * x); const float e = __expf(2.f * u); const float t = 1.f - 2.f / (e + 1.f); return 0.5f * x * (1.f + t); }

#define XB_TMO      128
#define XB_XCNT(j)  (256  + 64 * (j))
#define XB_XSUB(j)  (1280 + 64 * (j))
#define XB_XGEN(j)  (2304 + 64 * (j))
#define XB_TOP      3328
#define XB_TOPGEN   3392
#define XCD_BAR_WORDS 3456
#define XB_SPIN_CAP (1u << 18)

__device__ __forceinline__ unsigned xb_ld(unsigned* p)              { return __hip_atomic_load(p, __ATOMIC_RELAXED, __HIP_MEMORY_SCOPE_AGENT); }
__device__ __forceinline__ unsigned xb_add(unsigned* p, unsigned v) { return __hip_atomic_fetch_add(p, v, __ATOMIC_RELAXED, __HIP_MEMORY_SCOPE_AGENT); }
__device__ __forceinline__ unsigned xb_xcc_id() { return (unsigned)__builtin_amdgcn_s_getreg((3 << 11) | 20) & 0xFu; }
#define XB_SPIN(cond, bar) do { unsigned _sp = 0; while (cond) { __builtin_amdgcn_s_sleep(1); \
    if ((++_sp & 255u) == 0u) { if (xb_ld(&(bar)[XB_TMO])) break; if (_sp > XB_SPIN_CAP) { atomicAdd(&(bar)[XB_TMO], 1u); break; } } } } while (0)

struct XcdBarrier {
    unsigned* bar; unsigned x;
    volatile LAS unsigned* st;
};

__device__ __forceinline__ XcdBarrier xcd_barrier_post(unsigned* bar, volatile LAS unsigned* st) {
    XcdBarrier b; b.bar = bar; b.x = xb_xcc_id(); b.st = st;
    if (threadIdx.x == 0) (void)xb_add(&bar[XB_XCNT(b.x)], 1u);
    return b;
}
__device__ __forceinline__ void xcd_barrier_complete(unsigned* bar, unsigned x, unsigned& nloc, unsigned& nx) {
    const unsigned G = gridDim.x * gridDim.y * gridDim.z;
    unsigned sum, cnt, mine, sp = 0u;
    for (;;) {
        sum = 0u; cnt = 0u; mine = 0u;
#pragma unroll
        for (unsigned j = 0; j < 16; ++j) { const unsigned c = xb_ld(&bar[XB_XCNT(j)]); sum += c; cnt += (c > 0u) ? 1u : 0u; mine = (j == x) ? c : mine; }
        if (sum == G) break;
        __builtin_amdgcn_s_sleep(1);
        if ((++sp & 255u) == 0u) { if (xb_ld(&bar[XB_TMO])) break; if (sp > XB_SPIN_CAP) { atomicAdd(&bar[XB_TMO], 1u); break; } }
    }
    nloc = mine > 0u ? mine : 1u; nx = cnt > 0u ? cnt : 1u;
}

__device__ __forceinline__ void xcd_barrier(const XcdBarrier& b) {
    asm volatile("s_waitcnt vmcnt(0)" ::: "memory");
    __syncthreads();
    if (threadIdx.x == 0) {
        unsigned* bar = b.bar;
        __builtin_amdgcn_s_waitcnt(0);
        unsigned nloc = b.st[0], nx = b.st[1];
        if (nloc == 0u) { xcd_barrier_complete(bar, b.x, nloc, nx); b.st[0] = nloc; b.st[1] = nx; }
        const unsigned old = xb_add(&bar[XB_XSUB(b.x)], 1u);
        const unsigned gen = old / nloc;
        if (old + 1u == (gen + 1u) * nloc) {
            __builtin_amdgcn_fence(__ATOMIC_RELEASE, "agent");
            asm volatile("s_waitcnt vmcnt(0)" ::: "memory");
            const unsigned og = xb_add(&bar[XB_TOP], 1u);
            const unsigned tg = og / nx;
            if (og + 1u == (tg + 1u) * nx) xb_add(&bar[XB_TOPGEN], 1u);
            else XB_SPIN(xb_ld(&bar[XB_TOPGEN]) == tg, bar);
            __builtin_amdgcn_fence(__ATOMIC_ACQUIRE, "agent");
            xb_add(&bar[XB_XGEN(b.x)], 1u);
            asm volatile("s_waitcnt vmcnt(0)" ::: "memory");
        } else {
            XB_SPIN(xb_ld(&bar[XB_XGEN(b.x)]) == gen, bar);
            __builtin_amdgcn_fence(__ATOMIC_ACQUIRE, "agent");
            asm volatile("s_waitcnt vmcnt(0)" ::: "memory");
        }
    }
    __syncthreads();
}

namespace pg8 {
#define PG8_LAS __attribute__((address_space(3)))
typedef unsigned short bf16_t;
typedef short bf16x8 __attribute__((ext_vector_type(8)));
typedef float f32x4 __attribute__((ext_vector_type(4)));
typedef unsigned u32x4 __attribute__((ext_vector_type(4)));
constexpr int BM = 256, BK = 64, HALF = 128, HTB = HALF * BK * 2  , STAGE_BYTES = 8 * HTB, NXCD = 8, WGM = 8;

__host__ __device__ __forceinline__ int lds_byte(int r, int c) { const int st = (r >> 4) * 2 + (c >> 5), rr = r & 15, cc = c & 31, ob = rr * 64 + cc * 2; return st * 1024 + (ob ^ (((ob >> 9) & 1) << 5)); }
__host__ __device__ __forceinline__ void stage_rc(int b, int& R, int& C) { const int st = b / 1024, sb = b % 1024, swz = sb ^ (((sb >> 9) & 1) << 5); R = (st >> 1) * 16 + swz / 64; C = (st & 1) * 32 + (swz % 64) / 2; }
__host__ __device__ __forceinline__ int perm32(int rho) { const int n = rho >> 4, i = rho & 15; return 8 * (i >> 2) + 4 * n + (i & 3); }

struct Unit { int pm, pn; };
struct Gemm { const bf16_t* A; const bf16_t* Bt; int M, N, K; };

struct StaticOrder {
    int nM, nN, nwg, G, c;
    __host__ __device__ void init(int M, int N, int G_, int c_) { nM = M / BM; nN = N / BM; nwg = nM * nN; G = G_; c = c_; }
    __host__ __device__ bool next(int i, Unit& u) const {
        const long L = (long)i * G + c; if (L >= nwg) return false;
        int wgid = (int)L; { const int q = nwg / NXCD, r = nwg % NXCD, xcd = wgid % NXCD, off = wgid / NXCD; wgid = (xcd < r ? xcd * (q + 1) : r * (q + 1) + (xcd - r) * q) + off; }
        const int nig = WGM * nN, gid = wgid / nig, fm = gid * WGM, gsz = (nM - fm) < WGM ? (nM - fm) : WGM;
        u.pm = fm + ((wgid % nig) % gsz); u.pn = (wgid % nig) / gsz; return true;
    }
    __device__ __forceinline__ void a_ready(const Unit&) const {}
    __device__ __forceinline__ void done(const Unit&) const {}
};

template <class Epi, class Sched, bool STAMP = false>
__device__ __forceinline__ void gemm_phase(PG8_LAS unsigned char* lds, const Gemm g, const Sched& S, const Epi& E, unsigned long long* stamps) {
    const int tid = threadIdx.x, wid = __builtin_amdgcn_readfirstlane(tid >> 6), lane = tid & 63, wr = wid >> 2, wc = wid & 3, fr = lane & 15, fq = lane >> 4;
    const int K = g.K, nt = K / BK;
    int ts_lo = 0, ts_hi = 0, nts = 0; const unsigned long long rt_entry = STAMP ? (unsigned long long)wall_clock64() : 0ull;
#define PG8_STAMP() do { if (STAMP && wid == 0 && nts < 64) { const unsigned long long _c = (unsigned long long)clock64(); \
        ts_lo = (lane == nts) ? (int)(unsigned)_c : ts_lo; ts_hi = (lane == nts) ? (int)(unsigned)(_c >> 32) : ts_hi; ++nts; } } while (0)
    PG8_STAMP();
    unsigned voffA[2], voffB[2];
#pragma unroll
    for (int i = 0; i < 2; ++i) { int R, C; stage_rc(tid * 16 + i * 8192, R, C); const int Rb = Epi::PERM ? ((R & ~31) + perm32(R & 31)) : R;
        voffA[i] = (unsigned)(R * K + C) * 2u; voffB[i] = (unsigned)(Rb * K + C) * 2u; }
    const size_t kstep = (size_t)(BK * 2);
    const size_t hstep = (size_t)HALF * K * 2;
    const size_t tstep = 2 * hstep;
    const unsigned ldsw = (unsigned)wid * 1024u;
    const int aoff = lds_byte(wr * 64 + fr, fq * 8), boff = lds_byte(wc * 32 + fr, fq * 8);
#define PG8_SA(b, h) (((b) * 2 + (h)) * HTB)
#define PG8_SB(b, h) ((4 + (b) * 2 + (h)) * HTB)
#define PG8_STAGE(bufoff, gbase, voff) do { _Pragma("unroll") for (int _i = 0; _i < 2; ++_i) \
        __builtin_amdgcn_global_load_lds((const unsigned*)((const char*)(gbase) + (voff)[_i]), (PG8_LAS unsigned*)(lds + (bufoff) + ldsw + _i * 8192), 16, 0, 0); } while (0)
#define PG8_LDA(dst, b, h) do { _Pragma("unroll") for (int m = 0; m < 4; ++m) _Pragma("unroll") for (int k = 0; k < 2; ++k) dst[m][k] = *(const PG8_LAS bf16x8*)(lds + PG8_SA(b, h) + aoff + m * 2048 + k * 1024); } while (0)
#define PG8_LDB(dst, b, h) do { _Pragma("unroll") for (int n = 0; n < 2; ++n) _Pragma("unroll") for (int k = 0; k < 2; ++k) dst[n][k] = *(const PG8_LAS bf16x8*)(lds + PG8_SB(b, h) + boff + n * 2048 + k * 1024); } while (0)
#define PG8_MMA(ai, bj, At, Bt) do { __builtin_amdgcn_s_setprio(1); _Pragma("unroll") for (int m = 0; m < 4; ++m) _Pragma("unroll") for (int n = 0; n < 2; ++n) _Pragma("unroll") for (int k = 0; k < 2; ++k) \
        acc[ai][bj][m][n] = __builtin_amdgcn_mfma_f32_16x16x32_bf16(Bt[n][k], At[m][k], acc[ai][bj][m][n], 0, 0, 0); __builtin_amdgcn_s_setprio(0); } while (0)
#define PG8_WAIT_V(n) asm volatile("s_waitcnt vmcnt(" #n ")" ::: "memory")
#define PG8_WAIT_L(n) asm volatile("s_waitcnt lgkmcnt(" #n ")" ::: "memory")
#define PG8_BAR __builtin_amdgcn_s_barrier()
#define PG8_SCHED __builtin_amdgcn_sched_barrier(0)
    Unit cur, nxt; int ui = 0;
    if (!S.next(0, cur)) return;
    f32x4 acc[2][2][4][2];
#pragma unroll
    for (int a = 0; a < 2; ++a)
#pragma unroll
        for (int b = 0; b < 2; ++b)
#pragma unroll
            for (int m = 0; m < 4; ++m)
#pragma unroll
                for (int n = 0; n < 2; ++n) acc[a][b][m][n] = (f32x4){0.f, 0.f, 0.f, 0.f};
    bf16x8 At[4][2], B0[2][2], B1[2][2];
    const char* cA = (const char*)g.A + (size_t)cur.pm * tstep; const char* cB = (const char*)g.Bt + (size_t)cur.pn * tstep;
    S.a_ready(cur);
    PG8_STAGE(PG8_SB(0, 0), cB, voffB); PG8_STAGE(PG8_SA(0, 0), cA, voffA); PG8_STAGE(PG8_SB(0, 1), cB + hstep, voffB); PG8_STAGE(PG8_SA(0, 1), cA + hstep, voffA);
    if (wr == 1) PG8_BAR;
    PG8_WAIT_V(4); PG8_BAR;
    PG8_STAGE(PG8_SB(1, 0), cB + kstep, voffB); PG8_STAGE(PG8_SA(1, 0), cA + kstep, voffA); PG8_STAGE(PG8_SB(1, 1), cB + hstep + kstep, voffB);
    PG8_WAIT_V(6); PG8_BAR;
    PG8_STAMP();
    for (;;) {
        const bool has_next = S.next(ui + 1, nxt);
        const char* nA = has_next ? (const char*)g.A + (size_t)nxt.pm * tstep : cA; const char* nB = has_next ? (const char*)g.Bt + (size_t)nxt.pn * tstep : cB;
        for (int t = 0; t < nt; t += 2) {
            const bool last = (t == nt - 2);
            const char* a1 = cA + (size_t)(t + 1) * kstep;
            const char* a2 = last ? nA : cA + (size_t)(t + 2) * kstep; const char* b2 = last ? nB : cB + (size_t)(t + 2) * kstep;
            const char* a3 = a2 + kstep; const char* b3 = b2 + kstep;
            if (last && has_next) S.a_ready(nxt);
            PG8_LDB(B0, 0, 0); PG8_SCHED; PG8_LDA(At, 0, 0); PG8_STAGE(PG8_SA(1, 1), a1 + hstep, voffA);
            PG8_WAIT_L(8); PG8_BAR; PG8_WAIT_L(0); PG8_MMA(0, 0, At, B0); PG8_BAR; PG8_SCHED;
            PG8_LDB(B1, 0, 1); PG8_STAGE(PG8_SB(0, 0), b2, voffB);
            PG8_BAR; PG8_WAIT_L(0); PG8_MMA(0, 1, At, B1); PG8_BAR;
            PG8_LDA(At, 0, 1); PG8_STAGE(PG8_SA(0, 0), a2, voffA);
            PG8_BAR; PG8_WAIT_L(0); PG8_MMA(1, 0, At, B0); PG8_BAR; PG8_SCHED;
            PG8_STAGE(PG8_SB(0, 1), b2 + hstep, voffB);
            PG8_WAIT_V(6); PG8_BAR; PG8_MMA(1, 1, At, B1); PG8_BAR;
            PG8_LDB(B0, 1, 0); PG8_SCHED; PG8_LDA(At, 1, 0); PG8_STAGE(PG8_SA(0, 1), a2 + hstep, voffA);
            PG8_WAIT_L(8); PG8_BAR; PG8_WAIT_L(0); PG8_MMA(0, 0, At, B0); PG8_BAR; PG8_SCHED;
            PG8_LDB(B1, 1, 1); PG8_STAGE(PG8_SB(1, 0), b3, voffB);
            PG8_BAR; PG8_WAIT_L(0); PG8_MMA(0, 1, At, B1); PG8_BAR;
            PG8_LDA(At, 1, 1); PG8_STAGE(PG8_SA(1, 0), a3, voffA);
            PG8_BAR; PG8_WAIT_L(0); PG8_MMA(1, 0, At, B0); PG8_BAR; PG8_SCHED;
            PG8_STAGE(PG8_SB(1, 1), b3 + hstep, voffB);
            PG8_WAIT_V(6); PG8_BAR; PG8_MMA(1, 1, At, B1); PG8_BAR;
        }
        PG8_STAMP();
        if constexpr (!Epi::AFTER_DRAIN) { E(acc, cur, wr, wc, fr, fq); S.done(cur); }
        PG8_STAMP();
        if (!has_next) break;
#pragma unroll
        for (int a = 0; a < 2; ++a)
#pragma unroll
            for (int b = 0; b < 2; ++b)
#pragma unroll
                for (int m = 0; m < 4; ++m)
#pragma unroll
                    for (int n = 0; n < 2; ++n) acc[a][b][m][n] = (f32x4){0.f, 0.f, 0.f, 0.f};
        cur = nxt; cA = nA; cB = nB; ++ui;
    }
    PG8_WAIT_V(0);
    if (wr == 0) PG8_BAR;
    PG8_BAR;
    if constexpr (Epi::AFTER_DRAIN) { E.fused(acc, cur, wr, wc, fr, fq, lds, wid, lane); S.done(cur); }
    PG8_STAMP();
    if (STAMP && wid == 0) { stamps[lane] = lane < nts ? (((unsigned long long)(unsigned)ts_hi << 32) | (unsigned)ts_lo) : 0ull;
        if (lane == 62) stamps[62] = rt_entry; if (lane == 63) stamps[63] = (unsigned long long)wall_clock64(); }
#undef PG8_STAMP
#undef PG8_SA
#undef PG8_SB
#undef PG8_STAGE
#undef PG8_LDA
#undef PG8_LDB
#undef PG8_MMA
#undef PG8_WAIT_V
#undef PG8_WAIT_L
#undef PG8_BAR
#undef PG8_SCHED
}
}

struct EpiProj {
    static constexpr bool PERM = true, AFTER_DRAIN = false;
    bf16_t* O; int ldc; float* outK; float* outV; int kstart, vstart, kvw; const float* rope;
    __device__ __forceinline__ void operator()(const f32x4 (&acc)[2][2][4][2], const pg8::Unit& u, int wr, int wc, int fr, int fq) const {
        const int row0 = u.pm * 256 + wr * 64 + fr, colt = u.pn * 256, col0 = colt + wc * 32 + 8 * fq;
        const bool prompt = u.pm < (NP / 256);
        const bool do_rope = (rope != nullptr) && !prompt && colt < 2048;
        float* side = nullptr; int scol = 0;
        if (prompt) { if (colt >= kstart && colt < kstart + kvw) { side = outK; scol = col0 - kstart; } else if (colt >= vstart && colt < vstart + kvw) { side = outV; scol = col0 - vstart; } }
        const float sgn = fq < 2 ? -1.f : 1.f; const int fbase = (8 * fq) & 15;
#pragma unroll
        for (int ai = 0; ai < 2; ++ai)
#pragma unroll
            for (int m = 0; m < 4; ++m) {
                const int row = row0 + ai * 128 + m * 16;
                f32x4 cs0 = {1.f, 0.f, 1.f, 0.f}, cs1 = cs0, cs2 = cs0, cs3 = cs0;
                if (do_rope) { const int t = (row - NP) & (TS - 1); const int pos = (wc & 1) ? (t & 63) : (t >> 6); const f32x4* rp = (const f32x4*)(rope + (pos * 16 + fbase) * 2);
                    cs0 = rp[0]; cs1 = rp[1]; cs2 = rp[2]; cs3 = rp[3]; }
                bf16_t* rowp = O + (size_t)row * ldc + col0;
#pragma unroll
                for (int bj = 0; bj < 2; ++bj) {
                    f32x4 v0 = acc[ai][bj][m][0], v1 = acc[ai][bj][m][1];
                    if (do_rope) {
                        f32x4 p0, p1;
#pragma unroll
                        for (int j = 0; j < 4; ++j) { p0[j] = __shfl_xor(v0[j], 32); p1[j] = __shfl_xor(v1[j], 32); }
                        v0[0] = v0[0] * cs0[0] + sgn * p0[0] * cs0[1]; v0[1] = v0[1] * cs0[2] + sgn * p0[1] * cs0[3];
                        v0[2] = v0[2] * cs1[0] + sgn * p0[2] * cs1[1]; v0[3] = v0[3] * cs1[2] + sgn * p0[3] * cs1[3];
                        v1[0] = v1[0] * cs2[0] + sgn * p1[0] * cs2[1]; v1[1] = v1[1] * cs2[2] + sgn * p1[1] * cs2[3];
                        v1[2] = v1[2] * cs3[0] + sgn * p1[2] * cs3[1]; v1[3] = v1[3] * cs3[2] + sgn * p1[3] * cs3[3];
                    }
                    u32x4 w; w.x = cvt_pk_bf16(v0[0], v0[1]); w.y = cvt_pk_bf16(v0[2], v0[3]); w.z = cvt_pk_bf16(v1[0], v1[1]); w.w = cvt_pk_bf16(v1[2], v1[3]);
                    *(u32x4*)(rowp + bj * 128) = w;
                    if (side) { float* sp = side + (size_t)row * kvw + scol + bj * 128; *(f32x4*)sp = v0; *(f32x4*)(sp + 4) = v1; }
                }
            }
    }
};
struct EpiBf {
    static constexpr bool PERM = true, AFTER_DRAIN = false;
    bf16_t* O; int ldc;
    __device__ __forceinline__ void operator()(const f32x4 (&acc)[2][2][4][2], const pg8::Unit& u, int wr, int wc, int fr, int fq) const {
        const int row0 = u.pm * 256 + wr * 64 + fr, col0 = u.pn * 256 + wc * 32 + 8 * fq;
#pragma unroll
        for (int ai = 0; ai < 2; ++ai)
#pragma unroll
            for (int m = 0; m < 4; ++m) { bf16_t* rowp = O + (size_t)(row0 + ai * 128 + m * 16) * ldc + col0;
#pragma unroll
                for (int bj = 0; bj < 2; ++bj) { const f32x4 v0 = acc[ai][bj][m][0], v1 = acc[ai][bj][m][1];
                    u32x4 w; w.x = cvt_pk_bf16(v0[0], v0[1]); w.y = cvt_pk_bf16(v0[2], v0[3]); w.z = cvt_pk_bf16(v1[0], v1[1]); w.w = cvt_pk_bf16(v1[2], v1[3]);
                    *(u32x4*)(rowp + bj * 128) = w; } }
    }
};
struct EpiResid {
    static constexpr bool PERM = false, AFTER_DRAIN = false;
    const float* xin_p; const float* xin_s; float* xout; const float* gate;
    __device__ __forceinline__ void operator()(const f32x4 (&acc)[2][2][4][2], const pg8::Unit& u, int wr, int wc, int fr, int fq) const {
        const int row0 = u.pm * 256 + wr * 64 + fr, col0 = u.pn * 256 + wc * 32 + 4 * fq;
        const float* gp = gate + (size_t)cond_of_row(u.pm * 256) * 12288 + col0;
        f32x4 gv[2][2];
#pragma unroll
        for (int bj = 0; bj < 2; ++bj)
#pragma unroll
            for (int n = 0; n < 2; ++n) gv[bj][n] = *(const f32x4*)(gp + bj * 128 + n * 16);
#pragma unroll
        for (int ai = 0; ai < 2; ++ai)
#pragma unroll
            for (int m = 0; m < 4; ++m) { const int row = row0 + ai * 128 + m * 16;
                const float* ip = (row < NP ? xin_p + (size_t)row * D : xin_s + (size_t)(row - NP) * D) + col0; float* op = xout + (size_t)row * D + col0;
#pragma unroll
                for (int bj = 0; bj < 2; ++bj)
#pragma unroll
                    for (int n = 0; n < 2; ++n) { const f32x4 xi = *(const f32x4*)(ip + bj * 128 + n * 16); *(f32x4*)(op + bj * 128 + n * 16) = xi + gv[bj][n] * acc[ai][bj][m][n]; } }
    }
};

DI void tr_tile(const float* src, bf16_t* dst, int K, int N, int k0, int n0, LAS float* ts) {
    const int tid = threadIdx.x;
    { const int ty = tid >> 4, tx = tid & 15;
#pragma unroll
      for (int i = 0; i < 2; ++i) { const int k = ty + 32 * i; const f32x4 v = *(const f32x4*)(src + (size_t)(k0 + k) * N + n0 + 4 * tx);
          ts[k * 65 + 4 * tx + 0] = v[0]; ts[k * 65 + 4 * tx + 1] = v[1]; ts[k * 65 + 4 * tx + 2] = v[2]; ts[k * 65 + 4 * tx + 3] = v[3]; } }
    __syncthreads();
    { const int n = tid >> 3, kc = (tid & 7) * 8; float v[8];
#pragma unroll
      for (int j = 0; j < 8; ++j) v[j] = ts[(kc + j) * 65 + n];
      u32x4 w; w.x = cvt_pk_bf16(v[0], v[1]); w.y = cvt_pk_bf16(v[2], v[3]); w.z = cvt_pk_bf16(v[4], v[5]); w.w = cvt_pk_bf16(v[6], v[7]);
      *(u32x4*)(dst + (size_t)(n0 + n) * K + k0 + kc) = w; }
    __syncthreads();
}
DI void cvt_range(const float* src, bf16_t* dst, size_t n8, size_t gtid, size_t gstride) {
    for (size_t i = gtid; i < n8; i += gstride) { const f32x4 a = *(const f32x4*)(src + i * 8), b = *(const f32x4*)(src + i * 8 + 4);
        u32x4 w; w.x = cvt_pk_bf16(a[0], a[1]); w.y = cvt_pk_bf16(a[2], a[3]); w.z = cvt_pk_bf16(b[0], b[1]); w.w = cvt_pk_bf16(b[2], b[3]); *(u32x4*)(dst + i * 8) = w; }
}
DI void mod_unit(const Params& p, int u, LAS float* sl) {
    const int tid = threadIdx.x, lane = tid & 63, wave = tid >> 6;
    const int l = u / 384, cb = (u % 384) * 32, cl = tid & 7, ks = tid >> 3;
    for (int i = tid; i < 9 * 2048; i += NTHR) { const int c = i >> 11, k = i & 2047; const float v = (c == 0) ? p.c_ctx[k] : p.c[(c - 1) * 2048 + k]; sl[i] = v / (1.f + __expf(-v)); }
    __syncthreads();
    const float* W = p.w_mod + (size_t)l * 2048 * 12288 + cb + 4 * cl;
    float acc[9][4];
#pragma unroll
    for (int c = 0; c < 9; ++c)
#pragma unroll
        for (int j = 0; j < 4; ++j) acc[c][j] = 0.f;
#pragma unroll 4
    for (int kk = 0; kk < 32; ++kk) { const int k = kk * 64 + ks; const f32x4 w = *(const f32x4*)(W + (size_t)k * 12288);
#pragma unroll
        for (int c = 0; c < 9; ++c) { const float s = sl[c * 2048 + k];
#pragma unroll
            for (int j = 0; j < 4; ++j) acc[c][j] += s * w[j]; } }
#pragma unroll
    for (int c = 0; c < 9; ++c)
#pragma unroll
        for (int j = 0; j < 4; ++j) { float v = acc[c][j]; v += __shfl_xor(v, 8); v += __shfl_xor(v, 16); v += __shfl_xor(v, 32); acc[c][j] = v; }
    __syncthreads();
    LAS float* red = sl;
    if (lane < 8) {
#pragma unroll
        for (int c = 0; c < 9; ++c)
#pragma unroll
            for (int j = 0; j < 4; ++j) red[(wave * 9 + c) * 32 + cl * 4 + j] = acc[c][j]; }
    __syncthreads();
    if (tid < 288) { const int c = tid >> 5, col = tid & 31; float s = 0.f;
#pragma unroll
        for (int w = 0; w < 8; ++w) s += red[(w * 9 + c) * 32 + col];
        float* mod = (float*)(p.ws + WS_MOD);
        mod[(size_t)(l * 9 + c) * 12288 + cb + col] = s + p.b_mod[(size_t)l * 12288 + cb + col]; }
    __syncthreads();
}
constexpr int TR_T0 = 2560, TR_T1 = TR_T0 + 1024, TR_T2 = TR_T1 + 3072, TR_T3 = TR_T2 + 1024, TR_T4 = TR_T3 + 1024, TR_T5 = TR_T4 + 1024, TR_T6 = TR_T5 + 128;
constexpr int PRO_UNITS = TR_T6 + 768;

DI void prologue_phase(const Params& p, LAS unsigned char* lds) {
    const int tid = threadIdx.x;
    unsigned char* ws = p.ws;
    if (blockIdx.x == 0) {
        float* rope = (float*)(ws + WS_ROPE);
        for (int i = tid; i < 1024; i += NTHR) { const int pos = i >> 4, f = i & 15; const float inv = powf(10000.f, -(float)f / 16.f); const float ang = (float)pos * inv; rope[2 * i] = cosf(ang); rope[2 * i + 1] = sinf(ang); }
        if (tid < 64) { const float* lp = p.a_lambda; float a = lp[tid] * lp[64 + tid], b = lp[128 + tid] * lp[192 + tid]; a = wave_sum(a); b = wave_sum(b);
            if (tid == 0) ((float*)(ws + WS_SCAL))[0] = expf(a) - expf(b) + 0.2f; }
    }
    for (int u = blockIdx.x; u < PRO_UNITS; u += gridDim.x) {
        if (u < TR_T6) {
            const float* src; bf16_t* dst; int K = 2048, N, t;
            if (u < TR_T0) { src = p.even_w_in; dst = (bf16_t*)(ws + WS_WEI); N = EVEN_IN; t = u; }
            else if (u < TR_T1) { src = p.even_w_out; dst = (bf16_t*)(ws + WS_WEO); N = D; t = u - TR_T0; }
            else if (u < TR_T2) { src = p.odd_w_in; dst = (bf16_t*)(ws + WS_WOI); N = ODD_IN; t = u - TR_T1; }
            else if (u < TR_T3) { src = p.odd_w_out; dst = (bf16_t*)(ws + WS_WOO); N = D; t = u - TR_T2; }
            else if (u < TR_T4) { src = p.peer_w_q; dst = (bf16_t*)(ws + WS_WPQ); N = D; t = u - TR_T3; }
            else if (u < TR_T5) { src = p.peer_w_q + (size_t)D * D; dst = (bf16_t*)(ws + WS_WPQ) + (size_t)D * D; N = D; t = u - TR_T4; }
            else { t = u - TR_T5; const int mat = t >> 2; t &= 3; const int kind = mat >> 4, rest = mat & 15;
                src = (kind ? p.lru_w_i : p.lru_w_a) + (size_t)rest * 128 * 128; dst = (bf16_t*)(ws + WS_LRW) + (size_t)mat * 128 * 128; K = 128; N = 128; }
            const int ntn = N / 64; const int tk = t / ntn, tn = t % ntn;
            tr_tile(src, dst, K, N, tk * 64, tn * 64, (LAS float*)lds);
        } else mod_unit(p, u - TR_T6, (LAS float*)lds);
    }
    const size_t gtid = (size_t)blockIdx.x * NTHR + tid, gstride = (size_t)gridDim.x * NTHR;
    cvt_range(p.peer_sub_keys, (bf16_t*)(ws + WS_SK), (size_t)2 * 8 * 2 * 128 * 128 / 8, gtid, gstride);
    cvt_range(p.cache_a_k, (bf16_t*)(ws + WS_CAK), (size_t)8 * 512 * 1024 / 8, gtid, gstride);
    cvt_range(p.cache_a_v, (bf16_t*)(ws + WS_CAV), (size_t)8 * 512 * 1024 / 8, gtid, gstride);
    cvt_range(p.cache_c_k, (bf16_t*)(ws + WS_CCK), (size_t)8 * 512 * 2048 / 8, gtid, gstride);
    cvt_range(p.cache_c_v, (bf16_t*)(ws + WS_CCV), (size_t)8 * 512 * 2048 / 8, gtid, gstride);
    cvt_range(p.peer_u, (bf16_t*)(ws + WS_PU), (size_t)2 * PEER_N * D / 8, gtid, gstride);
    cvt_range(p.peer_v, (bf16_t*)(ws + WS_PV), (size_t)2 * PEER_N * D / 8, gtid, gstride);
}

DI void norm_row_store(const f32x4 (&x)[4][2], const float* g, const float* shift, const float* scale, bf16_t* hrow, int lane) {
    float ss = 0.f;
#pragma unroll
    for (int k = 0; k < 4; ++k)
#pragma unroll
        for (int q = 0; q < 2; ++q)
#pragma unroll
            for (int j = 0; j < 4; ++j) ss += x[k][q][j] * x[k][q][j];
    ss = wave_sum(ss);
    const float rs = rsqrtf(ss * (1.f / 2048.f) + 1e-6f);
#pragma unroll
    for (int k = 0; k < 4; ++k) { const int e = 512 * k + 8 * lane; float y[8];
#pragma unroll
        for (int q = 0; q < 2; ++q) { const f32x4 gv = *(const f32x4*)(g + e + 4 * q), sc = *(const f32x4*)(scale + e + 4 * q), sh = *(const f32x4*)(shift + e + 4 * q);
#pragma unroll
            for (int j = 0; j < 4; ++j) y[4 * q + j] = x[k][q][j] * rs * gv[j] * (1.f + sc[j]) + sh[j]; }
        u32x4 w; w.x = cvt_pk_bf16(y[0], y[1]); w.y = cvt_pk_bf16(y[2], y[3]); w.z = cvt_pk_bf16(y[4], y[5]); w.w = cvt_pk_bf16(y[6], y[7]);
        *(u32x4*)(hrow + e) = w; }
}
template <bool FIRST> DI void norm_phase(const Params& p, int l, int which) {
    const int tid = threadIdx.x, lane = tid & 63, wave = tid >> 6;
    const float* mod = (const float*)(p.ws + WS_MOD) + (size_t)l * 9 * 12288;
    const float* g = (which ? p.norm2_g : p.norm1_g) + l * D;
    bf16_t* h = (bf16_t*)(p.ws + WS_H);
    const float* xres = p.out + OUT_YP;
    for (int row = blockIdx.x * NWAVES + wave; row < NTOK; row += gridDim.x * NWAVES) {
        const float* xr = FIRST ? (row < NP ? p.x_prompt + (size_t)row * D : p.x_sample + (size_t)(row - NP) * D) : xres + (size_t)row * D;
        f32x4 x[4][2];
#pragma unroll
        for (int k = 0; k < 4; ++k)
#pragma unroll
            for (int q = 0; q < 2; ++q) x[k][q] = *(const f32x4*)(xr + 512 * k + 8 * lane + 4 * q);
        const float* mc = mod + (size_t)cond_of_row(row) * 12288 + which * 3 * D;
        norm_row_store(x, g, mc, mc + D, h + (size_t)row * D, lane);
    }
}

constexpr int KT_STRIDE = 272, VT_STRIDE = 320, KT_BYTES = 64 * KT_STRIDE, VT_BYTES = 64 * VT_STRIDE, ATT_BUF = KT_BYTES + VT_BYTES;
constexpr int ATT_RPB = 2 * ATT_BUF;
#define MFMA32(a, b, c) __builtin_amdgcn_mfma_f32_32x32x16_bf16((a), (b), (c), 0, 0, 0)
struct AttnArgs {
    const bf16_t* Q; int ldq;
    const bf16_t* K0; const bf16_t* V0; int n0, ld0;
    const bf16_t* K1; const bf16_t* V1; int n1, ld1;
    bf16_t* O; int ldo;
    float C;
    float lam; const float* subg;
    const float* rpb; int qr0, krlo;
};
DI void att_load(const AttnArgs& a, int j, u32x4 (&kv)[4], int tid) {
    int key0 = j * 64; const bf16_t* K = a.K0; const bf16_t* V = a.V0; int ld = a.ld0;
    if (key0 >= a.n0) { key0 -= a.n0; K = a.K1; V = a.V1; ld = a.ld1; }
#pragma unroll
    for (int i = 0; i < 2; ++i) { const int c = tid + 512 * i, row = c >> 4, ch = c & 15; const size_t off = (size_t)(key0 + row) * ld + ch * 8;
        kv[i] = *(const u32x4*)(K + off); kv[2 + i] = *(const u32x4*)(V + off); }
}
DI void att_store(LAS unsigned char* buf, const u32x4 (&kv)[4], int tid) {
#pragma unroll
    for (int i = 0; i < 2; ++i) { const int c = tid + 512 * i, row = c >> 4, ch = c & 15;
        *(LAS u32x4*)(buf + row * KT_STRIDE + ch * 16) = kv[i]; *(LAS u32x4*)(buf + KT_BYTES + row * VT_STRIDE + ch * 16) = kv[2 + i]; }
}
DI bf16x8 pack8(const f32x16& x, int s) {
    u32x4 w; w.x = cvt_pk_bf16(x[8 * s + 0], x[8 * s + 1]); w.y = cvt_pk_bf16(x[8 * s + 2], x[8 * s + 3]); w.z = cvt_pk_bf16(x[8 * s + 4], x[8 * s + 5]); w.w = cvt_pk_bf16(x[8 * s + 6], x[8 * s + 7]);
    return __builtin_bit_cast(bf16x8, w);
}
template <int MODE> DI void attn_unit(LAS unsigned char* lds, const AttnArgs& a) {
    const int tid = threadIdx.x, lane = tid & 63, wave = __builtin_amdgcn_readfirstlane(tid >> 6), r = lane & 31, h = lane >> 5;
    constexpr int NKS = MODE == 0 ? 4 : 8;
    const int qloc = MODE == 0 ? 32 * (wave >> 1) + r : 32 * wave + r;
    const int kofs = MODE == 0 ? 64 * (wave & 1) : 0;
    bf16x8 qf[NKS];
    { const bf16_t* qp = a.Q + (size_t)qloc * a.ldq + kofs + 8 * h;
#pragma unroll
      for (int ks = 0; ks < NKS; ++ks) qf[ks] = *(const bf16x8*)(qp + 16 * ks); }
    if (MODE == 2) { for (int i = tid; i < 465; i += NTHR) ((LAS float*)(lds + ATT_RPB))[i] = a.rpb[i] * 1.4426950408889634f; }
    f32x16 o[4];
#pragma unroll
    for (int d4 = 0; d4 < 4; ++d4)
#pragma unroll
        for (int i = 0; i < 16; ++i) o[d4][i] = 0.f;
    float m = -1e30f, l = 0.f;
    const int ntiles = (a.n0 + a.n1) >> 6;
    u32x4 kv[4];
    att_load(a, 0, kv, tid);
    att_store(lds, kv, tid);
    if (ntiles > 1) att_load(a, 1, kv, tid);
    __syncthreads();
    int qr = 0, qc = 0, cs = 0, rs = 0;
    if (MODE == 2) { qr = a.qr0 + (wave >> 1); qc = 32 * (wave & 1) + r; cs = min(max(qc - 8, 0), 48); rs = min(max(qr - 4, 0), 56); }
    const int tg = lane >> 4, ti = lane & 15, tq = ti >> 2, tp = ti & 3, thh = tg >> 1, tcg = tg & 1;
    const int vt_lane = (4 * thh + tq) * VT_STRIDE + (16 * tcg + 4 * tp) * 2;
    for (int j = 0; j < ntiles; ++j) {
        LAS unsigned char* buf = lds + (j & 1) * ATT_BUF;
        bool active = true; int kr = 0;
        if (MODE == 2 && j >= 8) { kr = a.krlo + (j - 8); const int wrs = min(max(a.qr0 + (wave >> 1) - 4, 0), 56); active = (kr >= wrs) && (kr < wrs + 8); }
        if (active) {
            f32x16 s0, s1;
#pragma unroll
            for (int i = 0; i < 16; ++i) { s0[i] = 0.f; s1[i] = 0.f; }
            const LAS unsigned char* kp = buf + r * KT_STRIDE + (kofs + 8 * h) * 2;
#pragma unroll
            for (int ks = 0; ks < NKS; ++ks) { const bf16x8 k0 = *(const LAS bf16x8*)(kp + ks * 32), k1 = *(const LAS bf16x8*)(kp + 32 * KT_STRIDE + ks * 32);
                s0 = MFMA32(k0, qf[ks], s0); s1 = MFMA32(k1, qf[ks], s1); }
#pragma unroll
            for (int i = 0; i < 16; ++i) { s0[i] *= a.C; s1[i] *= a.C; }
            if (MODE == 2 && j >= 8) {
                const LAS float* rp = (const LAS float*)(lds + ATT_RPB) + (kr - qr + 7) * 31 + 15 - qc;
#pragma unroll
                for (int i = 0; i < 16; ++i) { const int kc = (i & 3) + 8 * (i >> 2) + 4 * h;
                    s0[i] = (kc >= cs && kc < cs + 16) ? s0[i] + rp[kc] : -INFINITY;
                    s1[i] = (kc + 32 >= cs && kc + 32 < cs + 16) ? s1[i] + rp[kc + 32] : -INFINITY; }
            }
            float mx = fmaxf(s0[0], s1[0]);
#pragma unroll
            for (int i = 1; i < 16; ++i) mx = fmaxf(mx, fmaxf(s0[i], s1[i]));
            mx = fmaxf(mx, __shfl_xor(mx, 32));
            const float mn = fmaxf(m, mx), alpha = __builtin_amdgcn_exp2f(m - mn); m = mn;
            float ps = 0.f;
#pragma unroll
            for (int i = 0; i < 16; ++i) { s0[i] = __builtin_amdgcn_exp2f(s0[i] - mn); s1[i] = __builtin_amdgcn_exp2f(s1[i] - mn); ps += s0[i] + s1[i]; }
            l = l * alpha + ps;
#pragma unroll
            for (int d4 = 0; d4 < 4; ++d4)
#pragma unroll
                for (int i = 0; i < 16; ++i) o[d4][i] *= alpha;
            bf16x8 pf[4]; pf[0] = pack8(s0, 0); pf[1] = pack8(s0, 1); pf[2] = pack8(s1, 0); pf[3] = pack8(s1, 1);
            const LAS unsigned char* vp = buf + KT_BYTES + vt_lane;
#pragma unroll
            for (int kk = 0; kk < 4; ++kk)
#pragma unroll
                for (int d4 = 0; d4 < 4; ++d4) {
                    const s16x4 lo = __builtin_amdgcn_ds_read_tr16_b64_v4i16((LAS s16x4*)(vp + (16 * kk) * VT_STRIDE + 64 * d4));
                    const s16x4 hi = __builtin_amdgcn_ds_read_tr16_b64_v4i16((LAS s16x4*)(vp + (16 * kk + 8) * VT_STRIDE + 64 * d4));
                    bf16x8 vf; vf[0] = lo[0]; vf[1] = lo[1]; vf[2] = lo[2]; vf[3] = lo[3]; vf[4] = hi[0]; vf[5] = hi[1]; vf[6] = hi[2]; vf[7] = hi[3];
                    o[d4] = MFMA32(vf, pf[kk], o[d4]);
                }
        }
        if (j + 1 < ntiles) { att_store(lds + ((j + 1) & 1) * ATT_BUF, kv, tid); if (j + 2 < ntiles) att_load(a, j + 2, kv, tid); }
        __syncthreads();
    }
    l += __shfl_xor(l, 32);
    const float inv = 1.f / l;
    if (MODE != 0) {
        bf16_t* op = a.O + (size_t)qloc * a.ldo + 4 * h;
#pragma unroll
        for (int d4 = 0; d4 < 4; ++d4)
#pragma unroll
            for (int g4 = 0; g4 < 4; ++g4) { u32x2 w; w.x = cvt_pk_bf16(o[d4][4 * g4] * inv, o[d4][4 * g4 + 1] * inv); w.y = cvt_pk_bf16(o[d4][4 * g4 + 2] * inv, o[d4][4 * g4 + 3] * inv);
                *(u32x2*)(op + 32 * d4 + 8 * g4) = w; }
    } else {
        LAS float* ex = (LAS float*)lds + qloc * 132 + 4 * h;
        if (wave & 1) {
#pragma unroll
            for (int d4 = 0; d4 < 4; ++d4)
#pragma unroll
                for (int g4 = 0; g4 < 4; ++g4) { f32x4 v; v[0] = o[d4][4 * g4] * inv; v[1] = o[d4][4 * g4 + 1] * inv; v[2] = o[d4][4 * g4 + 2] * inv; v[3] = o[d4][4 * g4 + 3] * inv; *(LAS f32x4*)(ex + 32 * d4 + 8 * g4) = v; }
        }
        __syncthreads();
        if (!(wave & 1)) {
            float ss = 0.f;
#pragma unroll
            for (int d4 = 0; d4 < 4; ++d4)
#pragma unroll
                for (int g4 = 0; g4 < 4; ++g4) { const f32x4 o1 = *(const LAS f32x4*)(ex + 32 * d4 + 8 * g4);
#pragma unroll
                    for (int e = 0; e < 4; ++e) { const float v = o[d4][4 * g4 + e] * inv - a.lam * o1[e]; o[d4][4 * g4 + e] = v; ss += v * v; } }
            ss += __shfl_xor(ss, 32);
            const float rsn = rsqrtf(ss * (1.f / 128.f) + 1e-6f) * 0.8f;
            bf16_t* op = a.O + (size_t)qloc * a.ldo + 4 * h;
#pragma unroll
            for (int d4 = 0; d4 < 4; ++d4)
#pragma unroll
                for (int g4 = 0; g4 < 4; ++g4) { const f32x4 gv = *(const f32x4*)(a.subg + 32 * d4 + 8 * g4 + 4 * h);
                    u32x2 w; w.x = cvt_pk_bf16(o[d4][4 * g4] * rsn * gv[0], o[d4][4 * g4 + 1] * rsn * gv[1]); w.y = cvt_pk_bf16(o[d4][4 * g4 + 2] * rsn * gv[2], o[d4][4 * g4 + 3] * rsn * gv[3]);
                    *(u32x2*)(op + 32 * d4 + 8 * g4) = w; }
        }
        __syncthreads();
    }
}
DI int q_next(unsigned* ctr, volatile LAS unsigned* misc) {
    __syncthreads();
    if (threadIdx.x == 0) misc[0] = __hip_atomic_fetch_add(ctr, 1u, __ATOMIC_RELAXED, __HIP_MEMORY_SCOPE_AGENT);
    __syncthreads();
    return (int)misc[0];
}

constexpr int LR_W = 0;
constexpr int LR_WK = 128 * 272;
constexpr int LR_XR = LR_W + 2 * LR_WK;
constexpr int LR_XCB = LR_XR + 9216;
constexpr int LR_XC = LR_XCB + 32 * 272;
constexpr int LR_AS = LR_XC + 32 * 132 * 4;
constexpr int LR_BS = LR_AS + 32 * 144 * 4;
constexpr int LR_CAR = LR_BS + 32 * 144 * 4;
constexpr int LR_HC = LR_CAR + 4 * 128 * 8;
constexpr int LR_END = LR_HC + 512;
static_assert(LR_END <= LDS_MISC, "LRU LDS map");
#define MFMA16(a, b, c) __builtin_amdgcn_mfma_f32_16x16x32_bf16((a), (b), (c), 0, 0, 0)

DI void lru_unit(const Params& p, LAS unsigned char* lds, int seq, int blk) {
    const int tid = threadIdx.x, lane = tid & 63, wave = __builtin_amdgcn_readfirstlane(tid >> 6);
    const int T = seq < 32 ? TP : TS, tb = seq < 32 ? seq * TP : NP + (seq - 32) * TS, c0 = blk * 128;
    const bf16_t* proj = (const bf16_t*)(p.ws + WS_PROJ);
    float* HF = (float*)(p.ws + WS_H);
    bf16_t* mix = (bf16_t*)(p.ws + WS_MIX);
    const bf16_t* lrw = (const bf16_t*)(p.ws + WS_LRW);
    const int c = tid & 127, sub = tid >> 7;
    float cw[4];
#pragma unroll
    for (int j = 0; j < 4; ++j) cw[j] = p.lru_conv_w[j * 1024 + c0 + c];
    const float cb = p.lru_conv_b[c0 + c];
    const int tbk = wave & 1, cg = wave >> 1, fr = lane & 15, fq = lane >> 4;
    LAS float* HC = (LAS float*)(lds + LR_HC);
    for (int dir = 0; dir < 2; ++dir) {
        __syncthreads();
#pragma unroll
        for (int i = 0; i < 8; ++i) { const int ch = tid + 512 * i, kind = ch >> 11, rem = ch & 2047, o = rem >> 4, cc = rem & 15;
            const u32x4 w = *(const u32x4*)(lrw + ((size_t)((kind * 2 + dir) * 8 + blk) * 128 + o) * 128 + cc * 8);
            *(LAS u32x4*)(lds + LR_W + kind * LR_WK + o * 272 + cc * 16) = w; }
        float ba[2], bi[2], nsp[2];
#pragma unroll
        for (int cbk = 0; cbk < 2; ++cbk) { const int o = c0 + 32 * cg + 16 * cbk + fr; ba[cbk] = p.lru_b_a[dir * 1024 + o]; bi[cbk] = p.lru_b_i[dir * 1024 + o];
            const float lam = p.lru_lambda[dir * 1024 + o]; const float sp = (-lam > 20.f) ? -lam : log1pf(__expf(-lam)); nsp[cbk] = -8.f * sp; }
        if (tid < 128) HC[tid] = (seq >= 32) ? p.state_lru[(size_t)(seq - 32) * 2048 + dir * 1024 + c0 + tid] : 0.f;
        const int nch = T / 32;
        u32x4 xrn[2];
        auto ld_xr = [&](int t0) {
#pragma unroll
            for (int i = 0; i < 2; ++i) { const int ch = tid + 512 * i, row = ch >> 4, cc = ch & 15, t = t0 - 2 + row; u32x4 v = {0u, 0u, 0u, 0u};
                if (ch < 560 && t >= 0 && t < T) v = *(const u32x4*)(proj + (size_t)(tb + t) * EVEN_IN + 3072 + c0 + cc * 8);
                xrn[i] = v; } };
        ld_xr(dir ? T - 32 : 0);
        for (int chk = 0; chk < nch; ++chk) {
            const int t0 = dir ? T - 32 - 32 * chk : 32 * chk;
#pragma unroll
            for (int i = 0; i < 2; ++i) { const int ch = tid + 512 * i; if (ch < 560) *(LAS u32x4*)(lds + LR_XR + ch * 16) = xrn[i]; }
            if (chk + 1 < nch) ld_xr(dir ? t0 - 32 : t0 + 32);
            float hfv[8]; unsigned short gv[8];
            if (dir) {
#pragma unroll
                for (int i = 0; i < 8; ++i) { const int tl = 31 - (8 * sub + i); const size_t tok = (size_t)(tb + t0 + tl);
                    hfv[i] = HF[tok * 1024 + c0 + c]; gv[i] = proj[tok * EVEN_IN + 4096 + c0 + c]; } }
            __syncthreads();
            { const LAS bf16_t* xr = (const LAS bf16_t*)(lds + LR_XR);
#pragma unroll
              for (int i = 0; i < 8; ++i) { const int tl = 8 * sub + i; float acc = cb;
#pragma unroll
                  for (int j = 0; j < 4; ++j) acc += cw[j] * __uint_as_float(((unsigned)xr[(tl + j) * 128 + c]) << 16);
                  ((LAS float*)(lds + LR_XC))[tl * 132 + c] = acc;
                  ((LAS bf16_t*)(lds + LR_XCB))[tl * 136 + c] = (bf16_t)(cvt_pk_bf16(acc, 0.f) & 0xffffu); } }
            __syncthreads();
            { f32x4 acc[2][2];
#pragma unroll
              for (int k = 0; k < 2; ++k)
#pragma unroll
                  for (int cbk = 0; cbk < 2; ++cbk) acc[k][cbk] = (f32x4){0.f, 0.f, 0.f, 0.f};
#pragma unroll
              for (int ks = 0; ks < 4; ++ks) { const bf16x8 af = *(const LAS bf16x8*)(lds + LR_XCB + (16 * tbk + fr) * 272 + (32 * ks + 8 * fq) * 2);
#pragma unroll
                  for (int k = 0; k < 2; ++k)
#pragma unroll
                      for (int cbk = 0; cbk < 2; ++cbk) { const bf16x8 bf = *(const LAS bf16x8*)(lds + LR_W + k * LR_WK + (32 * cg + 16 * cbk + fr) * 272 + (32 * ks + 8 * fq) * 2);
                          acc[k][cbk] = MFMA16(af, bf, acc[k][cbk]); } }
#pragma unroll
              for (int cbk = 0; cbk < 2; ++cbk)
#pragma unroll
                  for (int rg = 0; rg < 4; ++rg) { const int tl = 16 * tbk + 4 * fq + rg, o = 32 * cg + 16 * cbk + fr;
                      const float rr = 1.f / (1.f + __expf(-(acc[0][cbk][rg] + ba[cbk]))), ii = 1.f / (1.f + __expf(-(acc[1][cbk][rg] + bi[cbk])));
                      const float la = rr * nsp[cbk], av = __expf(la), xc = ((const LAS float*)(lds + LR_XC))[tl * 132 + o];
                      const float bv = sqrtf(fmaxf(-expm1f(2.f * la), 0.f)) * ii * xc;
                      ((LAS float*)(lds + LR_AS))[tl * 144 + o] = av; ((LAS float*)(lds + LR_BS))[tl * 144 + o] = bv; } }
            __syncthreads();
            float hl[8], Pv[8];
            { float hh = 0.f, P = 1.f;
#pragma unroll
              for (int i = 0; i < 8; ++i) { const int u = 8 * sub + i, tl = dir ? 31 - u : u; const float av = ((const LAS float*)(lds + LR_AS))[tl * 144 + c], bv = ((const LAS float*)(lds + LR_BS))[tl * 144 + c];
                  hh = av * hh + bv; P *= av; hl[i] = hh; Pv[i] = P; }
              *(LAS f32x2*)(lds + LR_CAR + (sub * 128 + c) * 8) = (f32x2){P, hh}; }
            __syncthreads();
            float hin = HC[c];
#pragma unroll
            for (int s = 0; s < 3; ++s) if (s < sub) { const f32x2 e = *(const LAS f32x2*)(lds + LR_CAR + (s * 128 + c) * 8); hin = e[0] * hin + e[1]; }
            float hv[8];
#pragma unroll
            for (int i = 0; i < 8; ++i) hv[i] = hl[i] + Pv[i] * hin;
            __syncthreads();
            if (sub == 3) HC[c] = hv[7];
            if (!dir) {
#pragma unroll
                for (int i = 0; i < 8; ++i) { const int tl = 8 * sub + i; HF[(size_t)(tb + t0 + tl) * 1024 + c0 + c] = hv[i]; }
            } else {
#pragma unroll
                for (int i = 0; i < 8; ++i) { const int tl = 31 - (8 * sub + i); const float g = __uint_as_float(((unsigned)gv[i]) << 16);
                    const float ov = (hfv[i] + hv[i]) * gelu_tanh(g);
                    mix[(size_t)(tb + t0 + tl) * D + 1024 + c0 + c] = (bf16_t)(cvt_pk_bf16(ov, 0.f) & 0xffffu); }
            }
        }
        __syncthreads();
        if (seq < 32 && tid < 128) p.out[OUT_LRU + (size_t)seq * 2048 + dir * 1024 + c0 + tid] = HC[tid];
    }
    __syncthreads();
}

constexpr int PS_ROW = 129;
DI void peer_select_phase(const Params& p, int l, LAS unsigned char* lds) {
    const int tid = threadIdx.x, lane = tid & 63, wave = __builtin_amdgcn_readfirstlane(tid >> 6), fr = lane & 15, fq = lane >> 4;
    const bf16_t* qp = (const bf16_t*)(p.ws + WS_MIX);
    const bf16_t* skl = (const bf16_t*)(p.ws + WS_SK) + (size_t)l * 8 * 2 * 128 * 128;
    int* pidx = (int*)(p.ws + WS_PIDX); float* pgate = (float*)(p.ws + WS_PGATE);
    LAS float* SC = (LAS float*)lds;
    for (int u = blockIdx.x; u < 2560; u += gridDim.x) {
        const int head = u / 320, tile = u % 320, tok0 = tile * 128;
#pragma unroll
        for (int pp = 0; pp < 2; ++pp) {
            f32x4 acc[8];
#pragma unroll
            for (int kb = 0; kb < 8; ++kb) acc[kb] = (f32x4){0.f, 0.f, 0.f, 0.f};
            const bf16_t* qrow = qp + (size_t)(tok0 + 16 * wave + fr) * D + head * 256 + pp * 128 + 8 * fq;
            const bf16_t* kbase = skl + ((size_t)(head * 2 + pp) * 128 + fr) * 128 + 8 * fq;
#pragma unroll
            for (int ks = 0; ks < 4; ++ks) { const bf16x8 af = *(const bf16x8*)(qrow + 32 * ks);
#pragma unroll
                for (int kb = 0; kb < 8; ++kb) { const bf16x8 bf = *(const bf16x8*)(kbase + (size_t)(16 * kb) * 128 + 32 * ks); acc[kb] = MFMA16(af, bf, acc[kb]); } }
#pragma unroll
            for (int kb = 0; kb < 8; ++kb)
#pragma unroll
                for (int rg = 0; rg < 4; ++rg) SC[((16 * wave + 4 * fq + rg) * 2 + pp) * PS_ROW + 16 * kb + fr] = acc[kb][rg];
        }
        __syncthreads();
        { const int row = tid >> 1, half = tid & 1; LAS float* sp = SC + row * PS_ROW + 64 * half;
          float tv[16]; int tix[16];
#pragma unroll
          for (int i = 0; i < 16; ++i) { tv[i] = -INFINITY; tix[i] = 0; }
          for (int k = 0; k < 64; ++k) { float v = sp[k]; int vi = 64 * half + k;
              if (v > tv[15]) {
#pragma unroll
                  for (int i = 0; i < 16; ++i) { const bool gt = v > tv[i]; const float tvo = tv[i]; const int tio = tix[i]; tv[i] = gt ? v : tvo; tix[i] = gt ? vi : tio; v = gt ? tvo : v; vi = gt ? tio : vi; } } }
#pragma unroll
          for (int i = 0; i < 16; ++i) { sp[2 * i] = tv[i]; sp[2 * i + 1] = __int_as_float(tix[i]); } }
        __syncthreads();
        if (tid < 128) {
            float a[16], b[16];
            int ai[16], bi[16];
#pragma unroll
            for (int pp = 0; pp < 2; ++pp) { const LAS float* s0 = SC + (tid * 2 + pp) * PS_ROW; const LAS float* s1 = s0 + 64; int i0 = 0, i1 = 0;
#pragma unroll
                for (int n = 0; n < 16; ++n) { const float v0 = s0[2 * i0], v1 = s1[2 * i1]; const bool t0 = v0 >= v1; const float v = t0 ? v0 : v1; const int id = __float_as_int(t0 ? s0[2 * i0 + 1] : s1[2 * i1 + 1]);
                    if (pp == 0) { a[n] = v; ai[n] = id; } else { b[n] = v; bi[n] = id; } i0 += t0 ? 1 : 0; i1 += t0 ? 0 : 1; } }
            float cv[50]; int cc[50]; { int n = 0;
#pragma unroll
              for (int i = 0; i < 16; ++i)
#pragma unroll
                  for (int j = 0; j < 16; ++j) if ((i + 1) * (j + 1) <= 16) { cv[n] = a[i] + b[j]; cc[n] = ai[i] * 128 + bi[j]; ++n; } }
            float bs[16]; int bidx[16];
#pragma unroll
            for (int k = 0; k < 16; ++k) { float mv = cv[0]; int mi = 0;
#pragma unroll
                for (int n = 1; n < 50; ++n) { const bool gt = cv[n] > mv; mv = gt ? cv[n] : mv; mi = gt ? n : mi; }
                int sel = 0;
#pragma unroll
                for (int n = 0; n < 50; ++n) { const bool is = (n == mi); sel = is ? cc[n] : sel; cv[n] = is ? -INFINITY : cv[n]; }
                bs[k] = mv; bidx[k] = sel; }
            float den = 0.f; const float bmax = bs[0];
#pragma unroll
            for (int k = 0; k < 16; ++k) { bs[k] = __expf(bs[k] - bmax); den += bs[k]; }
            const float inv = 1.f / den;
            const size_t ob = (size_t)(tok0 + tid) * 128 + head * 16;
#pragma unroll
            for (int k4 = 0; k4 < 4; ++k4) { *(int4*)(pidx + ob + 4 * k4) = make_int4(bidx[4 * k4], bidx[4 * k4 + 1], bidx[4 * k4 + 2], bidx[4 * k4 + 3]);
                *(f32x4*)(pgate + ob + 4 * k4) = (f32x4){bs[4 * k4] * inv, bs[4 * k4 + 1] * inv, bs[4 * k4 + 2] * inv, bs[4 * k4 + 3] * inv}; }
        }
        __syncthreads();
    }
}

typedef __bf16 bf2_t __attribute__((ext_vector_type(2)));
DI float dot8(const u32x4& a, const u32x4& b, float acc) {
    asm("v_dot2c_f32_bf16 %0, %1, %2" : "+v"(acc) : "v"(a.x), "v"(b.x));
    asm("v_dot2c_f32_bf16 %0, %1, %2" : "+v"(acc) : "v"(a.y), "v"(b.y));
    asm("v_dot2c_f32_bf16 %0, %1, %2" : "+v"(acc) : "v"(a.z), "v"(b.z));
    asm("v_dot2c_f32_bf16 %0, %1, %2" : "+v"(acc) : "v"(a.w), "v"(b.w));
    return acc;
}
DI void axpy8(float (&o)[8], float s, const u32x4& v) {
    o[0] += s * bf_lo(v.x); o[1] += s * bf_hi(v.x); o[2] += s * bf_lo(v.y); o[3] += s * bf_hi(v.y); o[4] += s * bf_lo(v.z); o[5] += s * bf_hi(v.z); o[6] += s * bf_lo(v.w); o[7] += s * bf_hi(v.w);
}
#define PG_ISSUE(UB, VB, e) do { const int _id = __builtin_amdgcn_readlane(((e) < 64) ? idA : idB, (e) & 63); const bf16_t* _u = U + (size_t)_id * D + 8 * lane; const bf16_t* _v = V + (size_t)_id * D + 8 * lane; \
    _Pragma("unroll") for (int _k = 0; _k < 4; ++_k) { UB[_k] = *(const u32x4*)(_u + 512 * _k); VB[_k] = *(const u32x4*)(_v + 512 * _k); } } while (0)
#define PG_GATE(e) __int_as_float(__builtin_amdgcn_readlane(__float_as_int(((e) < 64) ? gA : gB), (e) & 63))
#define PG_DOT(UB) (dot8(xh[0], UB[0], 0.f) + dot8(xh[1], UB[1], 0.f) + dot8(xh[2], UB[2], 0.f) + dot8(xh[3], UB[3], 0.f))
#define PG_ACC(VB, act) do { _Pragma("unroll") for (int _k = 0; _k < 4; ++_k) axpy8(o[_k], (act), VB[_k]); } while (0)
#ifndef DBG_PEER_SCALE
#define DBG_PEER_SCALE 1.0f
#endif
DI void peer_gather_phase(const Params& p, int l, bool last) {
    const int tid = threadIdx.x, lane = tid & 63, wave = tid >> 6;
    const bf16_t* U = (const bf16_t*)(p.ws + WS_PU) + (size_t)l * PEER_N * D;
    const bf16_t* V = (const bf16_t*)(p.ws + WS_PV) + (size_t)l * PEER_N * D;
    const int* pidx = (const int*)(p.ws + WS_PIDX); const float* pgate = (const float*)(p.ws + WS_PGATE);
    bf16_t* hbuf = (bf16_t*)(p.ws + WS_H);
    float* xres = p.out + OUT_YP;
    const float* mod = (const float*)(p.ws + WS_MOD);
    for (int tok = blockIdx.x * NWAVES + wave; tok < NTOK; tok += gridDim.x * NWAVES) {
        u32x4 xh[4];
#pragma unroll
        for (int k = 0; k < 4; ++k) xh[k] = *(const u32x4*)(hbuf + (size_t)tok * D + 512 * k + 8 * lane);
        const int idA = pidx[(size_t)tok * 128 + lane], idB = pidx[(size_t)tok * 128 + 64 + lane];
        const float gA = pgate[(size_t)tok * 128 + lane], gB = pgate[(size_t)tok * 128 + 64 + lane];
        float o[4][8];
#pragma unroll
        for (int k = 0; k < 4; ++k)
#pragma unroll
            for (int j = 0; j < 8; ++j) o[k][j] = 0.f;
        u32x4 u0[4], v0[4], u1[4], v1[4], u2[4], v2[4];
#define PG_COMPUTE(UB, VB, e) do { const float _d = wave_sum(PG_DOT(UB)); const float _a = gelu_tanh(_d) * PG_GATE(e); PG_ACC(VB, _a); } while (0)
        PG_ISSUE(u0, v0, 0); PG_ISSUE(u1, v1, 1);
        for (int e = 0; e < 126; e += 3) {
            PG_ISSUE(u2, v2, e + 2); PG_COMPUTE(u0, v0, e);
            PG_ISSUE(u0, v0, e + 3); PG_COMPUTE(u1, v1, e + 1);
            PG_ISSUE(u1, v1, e + 4); PG_COMPUTE(u2, v2, e + 2);
        }
        PG_COMPUTE(u0, v0, 126); PG_COMPUTE(u1, v1, 127);
        const float* mc = mod + (size_t)(l * 9 + cond_of_row(tok)) * 12288;
        f32x4 xn[4][2];
#pragma unroll
        for (int k = 0; k < 4; ++k)
#pragma unroll
            for (int q = 0; q < 2; ++q) { const int eo = 512 * k + 8 * lane + 4 * q; const f32x4 xv = *(const f32x4*)(xres + (size_t)tok * D + eo), gt = *(const f32x4*)(mc + 5 * D + eo);
#pragma unroll
                for (int j = 0; j < 4; ++j) xn[k][q][j] = xv[j] + DBG_PEER_SCALE * gt[j] * o[k][4 * q + j]; }
        if (!last) {
#pragma unroll
            for (int k = 0; k < 4; ++k)
#pragma unroll
                for (int q = 0; q < 2; ++q) *(f32x4*)(xres + (size_t)tok * D + 512 * k + 8 * lane + 4 * q) = xn[k][q];
            const float* mn = mod + (size_t)((l + 1) * 9 + cond_of_row(tok)) * 12288;
            norm_row_store(xn, p.norm1_g + (l + 1) * D, mn, mn + D, hbuf + (size_t)tok * D, lane);
        } else {
            float ss = 0.f;
#pragma unroll
            for (int k = 0; k < 4; ++k)
#pragma unroll
                for (int q = 0; q < 2; ++q)
#pragma unroll
                    for (int j = 0; j < 4; ++j) ss += xn[k][q][j] * xn[k][q][j];
            ss = wave_sum(ss);
            const float rs = rsqrtf(ss * (1.f / 2048.f) + 1e-6f);
#pragma unroll
            for (int k = 0; k < 4; ++k)
#pragma unroll
                for (int q = 0; q < 2; ++q) { const int eo = 512 * k + 8 * lane + 4 * q; const f32x4 gv = *(const f32x4*)(p.final_norm_g + eo); f32x4 y;
#pragma unroll
                    for (int j = 0; j < 4; ++j) y[j] = xn[k][q][j] * rs * gv[j];
                    *(f32x4*)(xres + (size_t)tok * D + eo) = y; }
        }
    }
}

constexpr int N_PHASES = 16;
#ifndef MK_SPLIT
#define MK_SPLIT 0
#endif

__global__ void __launch_bounds__(NTHR, 2) mk_fwd(Params p) {
    extern __shared__ __attribute__((aligned(16))) unsigned char lds_raw[];
    LAS unsigned char* lds = (LAS unsigned char*)lds_raw;
    const int tid = threadIdx.x;
    volatile LAS unsigned* misc = (volatile LAS unsigned*)(lds + LDS_MISC);
    if (tid < 64) misc[tid] = 0u;
    __syncthreads();
    unsigned char* ws = p.ws;
    XcdBarrier bar; bar.bar = (unsigned*)(ws + WS_BAR); bar.x = 0; bar.st = nullptr;
    const bool fused = (p.ph_hi - p.ph_lo) > 1;
    if (fused) bar = xcd_barrier_post((unsigned*)(ws + WS_BAR), misc + 8);
#define PH(k) (p.ph_lo <= (k) && (k) < p.ph_hi)
#define SEAM(k) do { if (p.ph_lo <= (k) && (k) + 1 < p.ph_hi) xcd_barrier(bar); } while (0)
    float* mod = (float*)(ws + WS_MOD);
    bf16_t* hbuf = (bf16_t*)(ws + WS_H);
    bf16_t* proj = (bf16_t*)(ws + WS_PROJ);
    bf16_t* mix = (bf16_t*)(ws + WS_MIX);
    float* xres = p.out + OUT_YP;

    if (PH(0)) prologue_phase(p, lds);
    SEAM(0);
    if (PH(1)) norm_phase<true>(p, 0, 0);
    SEAM(1);
    if (PH(2)) {
        pg8::Gemm g; g.A = hbuf; g.Bt = (const bf16_t*)(ws + WS_WEI); g.M = NTOK; g.N = EVEN_IN; g.K = D;
        pg8::StaticOrder S; S.init(g.M, g.N, (int)gridDim.x, (int)blockIdx.x);
        EpiProj E; E.O = proj; E.ldc = EVEN_IN; E.outK = p.out + OUT_AK; E.outV = p.out + OUT_AV; E.kstart = 1024; E.vstart = 2048; E.kvw = 1024; E.rope = (const float*)(ws + WS_ROPE);
        pg8::gemm_phase<EpiProj, pg8::StaticOrder, false>(lds, g, S, E, nullptr);
    }
    SEAM(2);
    if (PH(3)) {
        unsigned* ctrL = (unsigned*)(ws + WS_CTR); unsigned* ctrA = ctrL + 64;
        for (;;) {
            const int u = q_next(ctrL, misc);
            if (u >= 320) break;
            const int seq = u < 64 ? 32 + (u >> 3) : ((u - 64) >> 3), blk = u & 7;
            lru_unit(p, lds, seq, blk);
        }
        const bf16_t* cak = (const bf16_t*)(ws + WS_CAK); const bf16_t* cav = (const bf16_t*)(ws + WS_CAV);
        const float lam = ((const float*)(ws + WS_SCAL))[0];
        for (;;) {
            const int u = q_next(ctrA, misc);
            if (u >= 2560) break;
            AttnArgs a; a.C = 0.125f * 1.4426950408889634f; a.lam = lam; a.subg = p.a_subln_g; a.rpb = nullptr; a.qr0 = 0; a.krlo = 0; a.ldq = EVEN_IN; a.ldo = D; a.ld1 = EVEN_IN;
            if (u < 2048) { const int b = u >> 8, head = (u & 255) >> 5, qb = u & 31; const size_t tb = NP + (size_t)b * TS;
                a.Q = proj + (tb + 128 * qb) * EVEN_IN + head * 128;
                a.K0 = cak + (size_t)b * PAST * 1024 + head * 128; a.V0 = cav + (size_t)b * PAST * 1024 + head * 128; a.n0 = PAST; a.ld0 = 1024;
                a.K1 = proj + tb * EVEN_IN + 1024 + head * 128; a.V1 = proj + tb * EVEN_IN + 2048 + head * 128; a.n1 = TS;
                a.O = mix + (tb + 128 * qb) * D + head * 128;
            } else { const int i = u - 2048, b = i >> 4, head = (i & 15) >> 1, half = i & 1; const size_t tb = (size_t)b * TP;
                a.Q = proj + (tb + 128 * half) * EVEN_IN + head * 128;
                a.K0 = proj + tb * EVEN_IN + 1024 + head * 128; a.V0 = proj + tb * EVEN_IN + 2048 + head * 128; a.n0 = TP; a.ld0 = EVEN_IN;
                a.K1 = a.K0; a.V1 = a.V0; a.n1 = 0;
                a.O = mix + (tb + 128 * half) * D + head * 128;
            }
            attn_unit<0>(lds, a);
        }
    }
    SEAM(3);
    if (PH(4)) {
        pg8::Gemm g; g.A = mix; g.Bt = (const bf16_t*)(ws + WS_WEO); g.M = NTOK; g.N = D; g.K = D;
        pg8::StaticOrder S; S.init(g.M, g.N, (int)gridDim.x, (int)blockIdx.x);
        EpiResid E; E.xin_p = p.x_prompt; E.xin_s = p.x_sample; E.xout = xres; E.gate = mod + 2 * D;
        pg8::gemm_phase<EpiResid, pg8::StaticOrder, false>(lds, g, S, E, nullptr);
    }
    SEAM(4);
    if (PH(5)) norm_phase<false>(p, 0, 1);
    SEAM(5);
    if (PH(6)) {
        pg8::Gemm g; g.A = hbuf; g.Bt = (const bf16_t*)(ws + WS_WPQ); g.M = NTOK; g.N = D; g.K = D;
        pg8::StaticOrder S; S.init(g.M, g.N, (int)gridDim.x, (int)blockIdx.x);
        EpiBf E; E.O = mix; E.ldc = D;
        pg8::gemm_phase<EpiBf, pg8::StaticOrder, false>(lds, g, S, E, nullptr);
    }
    SEAM(6);
    if (PH(7)) peer_select_phase(p, 0, lds);
    SEAM(7);
    if (PH(8)) peer_gather_phase(p, 0, false);
    SEAM(8);
    if (PH(9)) {
        pg8::Gemm g; g.A = hbuf; g.Bt = (const bf16_t*)(ws + WS_WOI); g.M = NTOK; g.N = ODD_IN; g.K = D;
        pg8::StaticOrder S; S.init(g.M, g.N, (int)gridDim.x, (int)blockIdx.x);
        EpiProj E; E.O = proj; E.ldc = ODD_IN; E.outK = p.out + OUT_CK; E.outV = p.out + OUT_CV; E.kstart = 2048; E.vstart = 4096; E.kvw = 2048; E.rope = nullptr;
        pg8::gemm_phase<EpiProj, pg8::StaticOrder, false>(lds, g, S, E, nullptr);
    }
    SEAM(9);
    if (PH(10)) {
        unsigned* ctrN = (unsigned*)(ws + WS_CTR) + 128; unsigned* ctrD = ctrN + 64;
        const bf16_t* cck = (const bf16_t*)(ws + WS_CCK); const bf16_t* ccv = (const bf16_t*)(ws + WS_CCV);
        for (;;) {
            const int u = q_next(ctrN, misc);
            if (u >= 2048) break;
            AttnArgs a; a.C = 0.08838834764831845f * 1.4426950408889634f; a.lam = 0.f; a.subg = nullptr; a.ldq = ODD_IN; a.ldo = D;
            const int b = u >> 8, head = (u & 255) >> 4, rb = u & 15; const size_t tb = NP + (size_t)b * TS;
            const int krlo = min(max(4 * rb - 4, 0), 56), krhi = min(max(4 * rb - 1, 0), 56) + 7;
            a.Q = proj + (tb + 256 * rb) * ODD_IN + head * 128;
            a.K0 = cck + (size_t)b * PAST * 2048 + head * 128; a.V0 = ccv + (size_t)b * PAST * 2048 + head * 128; a.n0 = PAST; a.ld0 = 2048;
            a.K1 = proj + (tb + 64 * krlo) * ODD_IN + 2048 + head * 128; a.V1 = proj + (tb + 64 * krlo) * ODD_IN + 4096 + head * 128; a.n1 = (krhi - krlo + 1) * 64; a.ld1 = ODD_IN;
            a.O = mix + (tb + 256 * rb) * D + head * 128; a.rpb = p.na_rpb + head * 465; a.qr0 = 4 * rb; a.krlo = krlo;
            attn_unit<2>(lds, a);
        }
        for (;;) {
            const int u = q_next(ctrD, misc);
            if (u >= 512) break;
            AttnArgs a; a.C = 0.08838834764831845f * 1.4426950408889634f; a.lam = 0.f; a.subg = nullptr; a.ldq = ODD_IN; a.ldo = D;
            const int b = u >> 4, head = u & 15; const size_t tb = (size_t)b * TP;
            a.Q = proj + tb * ODD_IN + head * 128;
            a.K0 = proj + tb * ODD_IN + 2048 + head * 128; a.V0 = proj + tb * ODD_IN + 4096 + head * 128; a.n0 = TP; a.ld0 = ODD_IN;
            a.K1 = a.K0; a.V1 = a.V0; a.n1 = 0; a.ld1 = ODD_IN;
            a.O = mix + tb * D + head * 128; a.rpb = nullptr; a.qr0 = 0; a.krlo = 0;
            attn_unit<1>(lds, a);
        }
    }
    SEAM(10);
    if (PH(11)) {
        pg8::Gemm g; g.A = mix; g.Bt = (const bf16_t*)(ws + WS_WOO); g.M = NTOK; g.N = D; g.K = D;
        pg8::StaticOrder S; S.init(g.M, g.N, (int)gridDim.x, (int)blockIdx.x);
        EpiResid E; E.xin_p = xres; E.xin_s = xres + (size_t)NP * D; E.xout = xres; E.gate = mod + (size_t)9 * 12288 + 2 * D;
        pg8::gemm_phase<EpiResid, pg8::StaticOrder, false>(lds, g, S, E, nullptr);
    }
    SEAM(11);
    if (PH(12)) norm_phase<false>(p, 1, 1);
    SEAM(12);
    if (PH(13)) {
        pg8::Gemm g; g.A = hbuf; g.Bt = (const bf16_t*)(ws + WS_WPQ) + (size_t)D * D; g.M = NTOK; g.N = D; g.K = D;
        pg8::StaticOrder S; S.init(g.M, g.N, (int)gridDim.x, (int)blockIdx.x);
        EpiBf E; E.O = mix; E.ldc = D;
        pg8::gemm_phase<EpiBf, pg8::StaticOrder, false>(lds, g, S, E, nullptr);
    }
    SEAM(13);
    if (PH(14)) peer_select_phase(p, 1, lds);
    SEAM(14);
    if (PH(15)) peer_gather_phase(p, 1, true);

#undef PH
#undef SEAM
}

extern "C" void kernel_launch(void* const* d_in, const int* in_sizes, int n_in, void* d_out, int out_size, void* d_ws, size_t ws_size, hipStream_t stream) {
    static int grid = 0;
    if (grid == 0) {
        if (n_in != 32 || ws_size < WS_END || (size_t)out_size != OUT_END) { fprintf(stderr, "kernel_launch: unexpected shapes: n_in %d out %d ws %zu (need %zu)\n", n_in, out_size, ws_size, (size_t)WS_END); grid = -1; return; }
        int dev = 0, cus = 0, per_cu = 0;
        if (hipGetDevice(&dev) != hipSuccess || hipDeviceGetAttribute(&cus, hipDeviceAttributeMultiprocessorCount, dev) != hipSuccess) { grid = -1; return; }
        if (hipFuncSetAttribute((const void*)mk_fwd, hipFuncAttributeMaxDynamicSharedMemorySize, LDS_BYTES) != hipSuccess) { fprintf(stderr, "kernel_launch: hipFuncSetAttribute failed\n"); grid = -1; return; }
        if (hipOccupancyMaxActiveBlocksPerMultiprocessor(&per_cu, (const void*)mk_fwd, NTHR, LDS_BYTES) != hipSuccess || per_cu < 1) { fprintf(stderr, "kernel_launch: occupancy query says %d\n", per_cu); }
        (void)hipGetLastError();
        grid = cus;
    }
    if (grid < 0) return;
    (void)hipMemsetAsync((char*)d_ws + WS_BAR, 0, WS_ZERO_BYTES, stream);
    Params p{};
    const float** pp = (const float**)&p;
    for (int i = 0; i < 32; ++i) pp[i] = (const float*)d_in[i];
    p.out = (float*)d_out; p.ws = (unsigned char*)d_ws;
#if MK_SPLIT
    for (int k = 0; k < N_PHASES; ++k) { p.ph_lo = k; p.ph_hi = k + 1; hipLaunchKernelGGL(mk_fwd, dim3(grid), dim3(NTHR), LDS_BYTES, stream, p); }
#else
    p.ph_lo = 0; p.ph_hi = N_PHASES;
    hipLaunchKernelGGL(mk_fwd, dim3(grid), dim3(NTHR), LDS_BYTES, stream, p);
#endif
    const hipError_t le = hipPeekAtLastError();
    if (le != hipSuccess) fprintf(stderr, "kernel_launch: launch failed: %s\n", hipGetErrorName(le));
}
```

```cpp
#include <hip/hip_runtime.h>
#include <stdint.h>
#include <stdio.h>

#define LAS __attribute__((address_space(3)))
typedef unsigned short bf16_t;
typedef short bf16x8 __attribute__((ext_vector_type(8)));
typedef short s16x4 __attribute__((ext_vector_type(4)));
typedef float f32x2 __attribute__((ext_vector_type(2)));
typedef float f32x4 __attribute__((ext_vector_type(4)));
typedef float f32x16 __attribute__((ext_vector_type(16)));
typedef unsigned u32x2 __attribute__((ext_vector_type(2)));
typedef unsigned u32x4 __attribute__((ext_vector_type(4)));
typedef unsigned u32x6 __attribute__((ext_vector_type(6)));
typedef float f32x32 __attribute__((ext_vector_type(32)));
typedef _Float16 h2 __attribute__((ext_vector_type(2)));
struct H16 { h2 v[16]; };
#define DI __device__ __forceinline__

constexpr int D = 2048, NP = 8192  , NS = 32768  , NTOK = NP + NS;
constexpr int TP = 256, TS = 4096, PAST = 512;
constexpr int EVEN_IN = 5120, ODD_IN = 6144;
constexpr int PEER_N = 16384;
constexpr int NWAVES = 8, NTHR = 512;
constexpr int LDS_BYTES = 147456;
constexpr int LDS_MISC = LDS_BYTES - 256;

constexpr size_t OUT_YP = 0, OUT_YS = OUT_YP + (size_t)NP * D, OUT_AK = OUT_YS + (size_t)NS * D, OUT_AV = OUT_AK + (size_t)NP * 1024,
                 OUT_LRU = OUT_AV + (size_t)NP * 1024, OUT_CK = OUT_LRU + 32 * 2 * 1024, OUT_CV = OUT_CK + (size_t)NP * 2048, OUT_END = OUT_CV + (size_t)NP * 2048;

constexpr size_t al256(size_t x) { return (x + 255) & ~(size_t)255; }
constexpr size_t WS_BAR = 0;
constexpr size_t WS_CTR = 16384;
constexpr size_t WS_ZERO_BYTES = 20480;
constexpr size_t WS_SCAL = WS_ZERO_BYTES;
constexpr size_t WS_ROPE = WS_SCAL + 256;
constexpr size_t WS_MOD = al256(WS_ROPE + 64 * 16 * 2 * 4);
constexpr size_t WS_WEI = al256(WS_MOD + (size_t)2 * 9 * 12288 * 4);
constexpr size_t WS_WEO = WS_WEI + (size_t)EVEN_IN * D * 2;
constexpr size_t WS_WOI = WS_WEO + (size_t)D * D * 2;
constexpr size_t WS_WOO = WS_WOI + (size_t)ODD_IN * D * 2;
constexpr size_t WS_WPQ = WS_WOO + (size_t)D * D * 2;
constexpr size_t WS_SK = WS_WPQ + (size_t)2 * D * D * 2;
constexpr size_t WS_LRW = WS_SK + (size_t)2 * 8 * 2 * 128 * 128 * 2;
constexpr size_t WS_CAK = WS_LRW + (size_t)2 * 2 * 8 * 128 * 128 * 2;
constexpr size_t WS_CAV = WS_CAK + (size_t)8 * 512 * 1024 * 2;
constexpr size_t WS_CCK = WS_CAV + (size_t)8 * 512 * 1024 * 2;
constexpr size_t WS_CCV = WS_CCK + (size_t)8 * 512 * 2048 * 2;
constexpr int PROW = 1536;
constexpr size_t WS_PU = WS_CCV + (size_t)8 * 512 * 2048 * 2;
constexpr size_t WS_PV = WS_PU + (size_t)2 * PEER_N * PROW;
constexpr size_t WS_PSU = WS_PV + (size_t)2 * PEER_N * PROW;
constexpr size_t WS_PSV = WS_PSU + (size_t)2 * PEER_N * 4;
constexpr size_t WS_H = WS_PSV + (size_t)2 * PEER_N * 4;
constexpr size_t WS_PROJ = WS_H + (size_t)NTOK * D * 2;
constexpr size_t WS_MIX = WS_PROJ + (size_t)NTOK * ODD_IN * 2;
constexpr size_t WS_PIDX = WS_MIX + (size_t)NTOK * D * 2;
constexpr size_t WS_PGATE = WS_PIDX + (size_t)NTOK * 128 * 4;
constexpr size_t WS_END = WS_PGATE + (size_t)NTOK * 128 * 4;

struct Params {
    const float *x_prompt, *x_sample, *cache_a_k, *cache_a_v, *state_lru, *cache_c_k, *cache_c_v, *c, *c_ctx, *w_mod, *b_mod, *norm1_g, *norm2_g, *final_norm_g,
        *even_w_in, *even_w_out, *a_lambda, *a_subln_g, *lru_conv_w, *lru_conv_b, *lru_w_a, *lru_b_a, *lru_w_i, *lru_b_i, *lru_lambda,
        *odd_w_in, *odd_w_out, *na_rpb, *peer_w_q, *peer_sub_keys, *peer_u, *peer_v;
    float* out; unsigned char* ws; int ph_lo, ph_hi;
};

DI unsigned cvt_pk_bf16(float lo, float hi) { unsigned r; asm volatile("v_cvt_pk_bf16_f32 %0, %1, %2" : "=v"(r) : "v"(lo), "v"(hi)); return r; }
DI float bf_lo(unsigned u) { return __uint_as_float(u << 16); }
DI float bf_hi(unsigned u) { return __uint_as_float(u & 0xffff0000u); }
DI float wave_sum(float v) { v += __shfl_xor(v, 1); v += __shfl_xor(v, 2); v += __shfl_xor(v, 4); v += __shfl_xor(v, 8); v += __shfl_xor(v, 16); v += __shfl_xor(v, 32); return v; }
template <int CTRL, int ROWMASK> DI float dpp_get(float v) { return __int_as_float(__builtin_amdgcn_update_dpp(0, __float_as_int(v), CTRL, ROWMASK, 0xf, false)); }
DI float wave_sum_dpp(float v) {
    v += dpp_get<0xB1, 0xf>(v); v += dpp_get<0x4E, 0xf>(v); v += dpp_get<0x141, 0xf>(v); v += dpp_get<0x140, 0xf>(v);
    v += dpp_get<0x142, 0xa>(v); v += dpp_get<0x143, 0xc>(v);
    return __int_as_float(__builtin_amdgcn_readlane(__float_as_int(v), 63));
}
DI int cond_of_row(int row) { return row < NP ? 0 : 1 + ((row - NP) >> 12); }
DI float gelu_tanh(float x) { const float u2 = (2.f * 0.7978845608028654f * 1.4426950408889634f) * (x + 0.044715f * x * x * x); return x * __builtin_amdgcn_rcpf(1.f + __builtin_amdgcn_exp2f(-u2)); }

#define XB_TMO      128
#define XB_XCNT(j)  (256  + 64 * (j))
#define XB_XSUB(j)  (1280 + 64 * (j))
#define XB_XGEN(j)  (2304 + 64 * (j))
#define XB_TOP      3328
#define XB_TOPGEN   3392
#define XCD_BAR_WORDS 3456
#define XB_SPIN_CAP (1u << 18)

__device__ __forceinline__ unsigned xb_ld(unsigned* p)              { return __hip_atomic_load(p, __ATOMIC_RELAXED, __HIP_MEMORY_SCOPE_AGENT); }
__device__ __forceinline__ unsigned xb_add(unsigned* p, unsigned v) { return __hip_atomic_fetch_add(p, v, __ATOMIC_RELAXED, __HIP_MEMORY_SCOPE_AGENT); }
__device__ __forceinline__ unsigned xb_xcc_id() { return (unsigned)__builtin_amdgcn_s_getreg((3 << 11) | 20) & 0xFu; }
#define XB_SPIN(cond, bar) do { unsigned _sp = 0; while (cond) { __builtin_amdgcn_s_sleep(1); \
    if ((++_sp & 255u) == 0u) { if (xb_ld(&(bar)[XB_TMO])) break; if (_sp > XB_SPIN_CAP) { atomicAdd(&(bar)[XB_TMO], 1u); break; } } } } while (0)

struct XcdBarrier {
    unsigned* bar; unsigned x;
    volatile LAS unsigned* st;
};

__device__ __forceinline__ XcdBarrier xcd_barrier_post(unsigned* bar, volatile LAS unsigned* st) {
    XcdBarrier b; b.bar = bar; b.x = xb_xcc_id(); b.st = st;
    if (threadIdx.x == 0) (void)xb_add(&bar[XB_XCNT(b.x)], 1u);
    return b;
}
__device__ __forceinline__ void xcd_barrier_complete(unsigned* bar, unsigned x, unsigned& nloc, unsigned& nx) {
    const unsigned G = gridDim.x * gridDim.y * gridDim.z;
    unsigned sum, cnt, mine, sp = 0u;
    for (;;) {
        sum = 0u; cnt = 0u; mine = 0u;
#pragma unroll
        for (unsigned j = 0; j < 16; ++j) { const unsigned c = xb_ld(&bar[XB_XCNT(j)]); sum += c; cnt += (c > 0u) ? 1u : 0u; mine = (j == x) ? c : mine; }
        if (sum == G) break;
        __builtin_amdgcn_s_sleep(1);
        if ((++sp & 255u) == 0u) { if (xb_ld(&bar[XB_TMO])) break; if (sp > XB_SPIN_CAP) { atomicAdd(&bar[XB_TMO], 1u); break; } }
    }
    nloc = mine > 0u ? mine : 1u; nx = cnt > 0u ? cnt : 1u;
}

__device__ __forceinline__ void xcd_barrier(const XcdBarrier& b) {
    asm volatile("s_waitcnt vmcnt(0)" ::: "memory");
    __syncthreads();
    if (threadIdx.x == 0) {
        unsigned* bar = b.bar;
        __builtin_amdgcn_s_waitcnt(0);
        unsigned nloc = b.st[0], nx = b.st[1];
        if (nloc == 0u) { xcd_barrier_complete(bar, b.x, nloc, nx); b.st[0] = nloc; b.st[1] = nx; }
        const unsigned old = xb_add(&bar[XB_XSUB(b.x)], 1u);
        const unsigned gen = old / nloc;
        if (old + 1u == (gen + 1u) * nloc) {
            __builtin_amdgcn_fence(__ATOMIC_RELEASE, "agent");
            asm volatile("s_waitcnt vmcnt(0)" ::: "memory");
            const unsigned og = xb_add(&bar[XB_TOP], 1u);
            const unsigned tg = og / nx;
            if (og + 1u == (tg + 1u) * nx) xb_add(&bar[XB_TOPGEN], 1u);
            else XB_SPIN(xb_ld(&bar[XB_TOPGEN]) == tg, bar);
            __builtin_amdgcn_fence(__ATOMIC_ACQUIRE, "agent");
            xb_add(&bar[XB_XGEN(b.x)], 1u);
            asm volatile("s_waitcnt vmcnt(0)" ::: "memory");
        } else {
            XB_SPIN(xb_ld(&bar[XB_XGEN(b.x)]) == gen, bar);
            __builtin_amdgcn_fence(__ATOMIC_ACQUIRE, "agent");
            asm volatile("s_waitcnt vmcnt(0)" ::: "memory");
        }
    }
    __syncthreads();
}

namespace pg8 {
#define PG8_LAS __attribute__((address_space(3)))
typedef unsigned short bf16_t;
typedef short bf16x8 __attribute__((ext_vector_type(8)));
typedef float f32x4 __attribute__((ext_vector_type(4)));
typedef unsigned u32x4 __attribute__((ext_vector_type(4)));
constexpr int BM = 256, BK = 64, HALF = 128, HTB = HALF * BK * 2  , STAGE_BYTES = 8 * HTB, NXCD = 8, WGM = 8;

__host__ __device__ __forceinline__ int lds_byte(int r, int c) { const int st = (r >> 4) * 2 + (c >> 5), rr = r & 15, cc = c & 31, ob = rr * 64 + cc * 2; return st * 1024 + (ob ^ (((ob >> 9) & 1) << 5)); }
__host__ __device__ __forceinline__ void stage_rc(int b, int& R, int& C) { const int st = b / 1024, sb = b % 1024, swz = sb ^ (((sb >> 9) & 1) << 5); R = (st >> 1) * 16 + swz / 64; C = (st & 1) * 32 + (swz % 64) / 2; }
__host__ __device__ __forceinline__ int perm32(int rho) { const int n = rho >> 4, i = rho & 15; return 8 * (i >> 2) + 4 * n + (i & 3); }

struct Unit { int pm, pn; };
struct Gemm { const bf16_t* A; const bf16_t* Bt; int M, N, K; };

struct StaticOrder {
    int nM, nN, nwg, G, c;
    __host__ __device__ void init(int M, int N, int G_, int c_) { nM = M / BM; nN = N / BM; nwg = nM * nN; G = G_; c = c_; }
    __host__ __device__ bool next(int i, Unit& u) const {
        const long L = (long)i * G + c; if (L >= nwg) return false;
        int wgid = (int)L; { const int q = nwg / NXCD, r = nwg % NXCD, xcd = wgid % NXCD, off = wgid / NXCD; wgid = (xcd < r ? xcd * (q + 1) : r * (q + 1) + (xcd - r) * q) + off; }
        const int nig = WGM * nN, gid = wgid / nig, fm = gid * WGM, gsz = (nM - fm) < WGM ? (nM - fm) : WGM;
        u.pm = fm + ((wgid % nig) % gsz); u.pn = (wgid % nig) / gsz; return true;
    }
    __device__ __forceinline__ void a_ready(const Unit&) const {}
    __device__ __forceinline__ void done(const Unit&) const {}
};

template <class Epi, class Sched, bool STAMP = false>
__device__ __forceinline__ void gemm_phase(PG8_LAS unsigned char* lds, const Gemm g, const Sched& S, const Epi& E, unsigned long long* stamps) {
    const int tid = threadIdx.x, wid = __builtin_amdgcn_readfirstlane(tid >> 6), lane = tid & 63, wr = wid >> 2, wc = wid & 3, fr = lane & 15, fq = lane >> 4;
    const int K = g.K, nt = K / BK;
    int ts_lo = 0, ts_hi = 0, nts = 0; const unsigned long long rt_entry = STAMP ? (unsigned long long)wall_clock64() : 0ull;
#define PG8_STAMP() do { if (STAMP && wid == 0 && nts < 64) { const unsigned long long _c = (unsigned long long)clock64(); \
        ts_lo = (lane == nts) ? (int)(unsigned)_c : ts_lo; ts_hi = (lane == nts) ? (int)(unsigned)(_c >> 32) : ts_hi; ++nts; } } while (0)
    PG8_STAMP();
    unsigned voffA[2], voffB[2];
#pragma unroll
    for (int i = 0; i < 2; ++i) { int R, C; stage_rc(tid * 16 + i * 8192, R, C); const int Rb = Epi::PERM ? ((R & ~31) + perm32(R & 31)) : R;
        voffA[i] = (unsigned)(R * K + C) * 2u; voffB[i] = (unsigned)(Rb * K + C) * 2u; }
    const size_t kstep = (size_t)(BK * 2);
    const size_t hstep = (size_t)HALF * K * 2;
    const size_t tstep = 2 * hstep;
    const unsigned ldsw = (unsigned)wid * 1024u;
    const int aoff = lds_byte(wr * 64 + fr, fq * 8), boff = lds_byte(wc * 32 + fr, fq * 8);
#define PG8_SA(b, h) (((b) * 2 + (h)) * HTB)
#define PG8_SB(b, h) ((4 + (b) * 2 + (h)) * HTB)
#define PG8_STAGE(bufoff, gbase, voff) do { _Pragma("unroll") for (int _i = 0; _i < 2; ++_i) \
        __builtin_amdgcn_global_load_lds((const unsigned*)((const char*)(gbase) + (voff)[_i]), (PG8_LAS unsigned*)(lds + (bufoff) + ldsw + _i * 8192), 16, 0, 0); } while (0)
#define PG8_LDA(dst, b, h) do { _Pragma("unroll") for (int m = 0; m < 4; ++m) _Pragma("unroll") for (int k = 0; k < 2; ++k) dst[m][k] = *(const PG8_LAS bf16x8*)(lds + PG8_SA(b, h) + aoff + m * 2048 + k * 1024); } while (0)
#define PG8_LDB(dst, b, h) do { _Pragma("unroll") for (int n = 0; n < 2; ++n) _Pragma("unroll") for (int k = 0; k < 2; ++k) dst[n][k] = *(const PG8_LAS bf16x8*)(lds + PG8_SB(b, h) + boff + n * 2048 + k * 1024); } while (0)
#define PG8_MMA(ai, bj, At, Bt) do { __builtin_amdgcn_s_setprio(1); _Pragma("unroll") for (int m = 0; m < 4; ++m) _Pragma("unroll") for (int n = 0; n < 2; ++n) _Pragma("unroll") for (int k = 0; k < 2; ++k) \
        acc[ai][bj][m][n] = __builtin_amdgcn_mfma_f32_16x16x32_bf16(Bt[n][k], At[m][k], acc[ai][bj][m][n], 0, 0, 0); __builtin_amdgcn_s_setprio(0); } while (0)
#define PG8_WAIT_V(n) asm volatile("s_waitcnt vmcnt(" #n ")" ::: "memory")
#define PG8_WAIT_L(n) asm volatile("s_waitcnt lgkmcnt(" #n ")" ::: "memory")
#define PG8_BAR __builtin_amdgcn_s_barrier()
#define PG8_SCHED __builtin_amdgcn_sched_barrier(0)
    Unit cur, nxt; int ui = 0;
    if (!S.next(0, cur)) return;
    f32x4 acc[2][2][4][2];
#pragma unroll
    for (int a = 0; a < 2; ++a)
#pragma unroll
        for (int b = 0; b < 2; ++b)
#pragma unroll
            for (int m = 0; m < 4; ++m)
#pragma unroll
                for (int n = 0; n < 2; ++n) acc[a][b][m][n] = (f32x4){0.f, 0.f, 0.f, 0.f};
    bf16x8 At[4][2], B0[2][2], B1[2][2];
    const char* cA = (const char*)g.A + (size_t)cur.pm * tstep; const char* cB = (const char*)g.Bt + (size_t)cur.pn * tstep;
    S.a_ready(cur);
    PG8_STAGE(PG8_SB(0, 0), cB, voffB); PG8_STAGE(PG8_SA(0, 0), cA, voffA); PG8_STAGE(PG8_SB(0, 1), cB + hstep, voffB); PG8_STAGE(PG8_SA(0, 1), cA + hstep, voffA);
    if (wr == 1) PG8_BAR;
    PG8_WAIT_V(4); PG8_BAR;
    PG8_STAGE(PG8_SB(1, 0), cB + kstep, voffB); PG8_STAGE(PG8_SA(1, 0), cA + kstep, voffA); PG8_STAGE(PG8_SB(1, 1), cB + hstep + kstep, voffB);
    PG8_WAIT_V(6); PG8_BAR;
    PG8_STAMP();
    for (;;) {
        const bool has_next = S.next(ui + 1, nxt);
        const char* nA = has_next ? (const char*)g.A + (size_t)nxt.pm * tstep : cA; const char* nB = has_next ? (const char*)g.Bt + (size_t)nxt.pn * tstep : cB;
        for (int t = 0; t < nt; t += 2) {
            const bool last = (t == nt - 2);
            const char* a1 = cA + (size_t)(t + 1) * kstep;
            const char* a2 = last ? nA : cA + (size_t)(t + 2) * kstep; const char* b2 = last ? nB : cB + (size_t)(t + 2) * kstep;
            const char* a3 = a2 + kstep; const char* b3 = b2 + kstep;
            if (last && has_next) S.a_ready(nxt);
            PG8_LDB(B0, 0, 0); PG8_SCHED; PG8_LDA(At, 0, 0); PG8_STAGE(PG8_SA(1, 1), a1 + hstep, voffA);
            PG8_WAIT_L(8); PG8_BAR; PG8_WAIT_L(0); PG8_MMA(0, 0, At, B0); PG8_BAR; PG8_SCHED;
            PG8_LDB(B1, 0, 1); PG8_STAGE(PG8_SB(0, 0), b2, voffB);
            PG8_BAR; PG8_WAIT_L(0); PG8_MMA(0, 1, At, B1); PG8_BAR;
            PG8_LDA(At, 0, 1); PG8_STAGE(PG8_SA(0, 0), a2, voffA);
            PG8_BAR; PG8_WAIT_L(0); PG8_MMA(1, 0, At, B0); PG8_BAR; PG8_SCHED;
            PG8_STAGE(PG8_SB(0, 1), b2 + hstep, voffB);
            PG8_WAIT_V(6); PG8_BAR; PG8_MMA(1, 1, At, B1); PG8_BAR;
            PG8_LDB(B0, 1, 0); PG8_SCHED; PG8_LDA(At, 1, 0); PG8_STAGE(PG8_SA(0, 1), a2 + hstep, voffA);
            PG8_WAIT_L(8); PG8_BAR; PG8_WAIT_L(0); PG8_MMA(0, 0, At, B0); PG8_BAR; PG8_SCHED;
            PG8_LDB(B1, 1, 1); PG8_STAGE(PG8_SB(1, 0), b3, voffB);
            PG8_BAR; PG8_WAIT_L(0); PG8_MMA(0, 1, At, B1); PG8_BAR;
            PG8_LDA(At, 1, 1); PG8_STAGE(PG8_SA(1, 0), a3, voffA);
            PG8_BAR; PG8_WAIT_L(0); PG8_MMA(1, 0, At, B0); PG8_BAR; PG8_SCHED;
            PG8_STAGE(PG8_SB(1, 1), b3 + hstep, voffB);
            PG8_WAIT_V(6); PG8_BAR; PG8_MMA(1, 1, At, B1); PG8_BAR;
        }
        PG8_STAMP();
        if constexpr (!Epi::AFTER_DRAIN) { E(acc, cur, wr, wc, fr, fq); S.done(cur); }
        PG8_STAMP();
        if (!has_next) break;
#pragma unroll
        for (int a = 0; a < 2; ++a)
#pragma unroll
            for (int b = 0; b < 2; ++b)
#pragma unroll
                for (int m = 0; m < 4; ++m)
#pragma unroll
                    for (int n = 0; n < 2; ++n) acc[a][b][m][n] = (f32x4){0.f, 0.f, 0.f, 0.f};
        cur = nxt; cA = nA; cB = nB; ++ui;
    }
    PG8_WAIT_V(0);
    if (wr == 0) PG8_BAR;
    PG8_BAR;
    if constexpr (Epi::AFTER_DRAIN) { E.fused(acc, cur, wr, wc, fr, fq, lds, wid, lane); S.done(cur); }
    PG8_STAMP();
    if (STAMP && wid == 0) { stamps[lane] = lane < nts ? (((unsigned long long)(unsigned)ts_hi << 32) | (unsigned)ts_lo) : 0ull;
        if (lane == 62) stamps[62] = rt_entry; if (lane == 63) stamps[63] = (unsigned long long)wall_clock64(); }
#undef PG8_STAMP
#undef PG8_SA
#undef PG8_SB
#undef PG8_STAGE
#undef PG8_LDA
#undef PG8_LDB
#undef PG8_MMA
#undef PG8_WAIT_V
#undef PG8_WAIT_L
#undef PG8_BAR
#undef PG8_SCHED
}
}

struct EpiProj {
    static constexpr bool PERM = true, AFTER_DRAIN = false;
    bf16_t* O; int ldc; float* outK; float* outV; int kstart, vstart, kvw; const float* rope;
    __device__ __forceinline__ void operator()(const f32x4 (&acc)[2][2][4][2], const pg8::Unit& u, int wr, int wc, int fr, int fq) const {
        const int row0 = u.pm * 256 + wr * 64 + fr, colt = u.pn * 256, col0 = colt + wc * 32 + 8 * fq;
        const bool prompt = u.pm < (NP / 256);
        const bool do_rope = (rope != nullptr) && !prompt && colt < 2048;
        float* side = nullptr; int scol = 0;
        if (prompt) { if (colt >= kstart && colt < kstart + kvw) { side = outK; scol = col0 - kstart; } else if (colt >= vstart && colt < vstart + kvw) { side = outV; scol = col0 - vstart; } }
        const float sgn = fq < 2 ? -1.f : 1.f; const int fbase = (8 * fq) & 15;
#pragma unroll
        for (int ai = 0; ai < 2; ++ai)
#pragma unroll
            for (int m = 0; m < 4; ++m) {
                const int row = row0 + ai * 128 + m * 16;
                f32x4 cs0 = {1.f, 0.f, 1.f, 0.f}, cs1 = cs0, cs2 = cs0, cs3 = cs0;
                if (do_rope) { const int t = (row - NP) & (TS - 1); const int pos = (wc & 1) ? (t & 63) : (t >> 6); const f32x4* rp = (const f32x4*)(rope + (pos * 16 + fbase) * 2);
                    cs0 = rp[0]; cs1 = rp[1]; cs2 = rp[2]; cs3 = rp[3]; }
                bf16_t* rowp = O + (size_t)row * ldc + col0;
#pragma unroll
                for (int bj = 0; bj < 2; ++bj) {
                    f32x4 v0 = acc[ai][bj][m][0], v1 = acc[ai][bj][m][1];
                    if (do_rope) {
                        f32x4 p0, p1;
#pragma unroll
                        for (int j = 0; j < 4; ++j) { p0[j] = __shfl_xor(v0[j], 32); p1[j] = __shfl_xor(v1[j], 32); }
                        v0[0] = v0[0] * cs0[0] + sgn * p0[0] * cs0[1]; v0[1] = v0[1] * cs0[2] + sgn * p0[1] * cs0[3];
                        v0[2] = v0[2] * cs1[0] + sgn * p0[2] * cs1[1]; v0[3] = v0[3] * cs1[2] + sgn * p0[3] * cs1[3];
                        v1[0] = v1[0] * cs2[0] + sgn * p1[0] * cs2[1]; v1[1] = v1[1] * cs2[2] + sgn * p1[1] * cs2[3];
                        v1[2] = v1[2] * cs3[0] + sgn * p1[2] * cs3[1]; v1[3] = v1[3] * cs3[2] + sgn * p1[3] * cs3[3];
                    }
                    u32x4 w; w.x = cvt_pk_bf16(v0[0], v0[1]); w.y = cvt_pk_bf16(v0[2], v0[3]); w.z = cvt_pk_bf16(v1[0], v1[1]); w.w = cvt_pk_bf16(v1[2], v1[3]);
                    *(u32x4*)(rowp + bj * 128) = w;
                    if (side) { float* sp = side + (size_t)row * kvw + scol + bj * 128; *(f32x4*)sp = v0; *(f32x4*)(sp + 4) = v1; }
                }
            }
    }
};
struct EpiBf {
    static constexpr bool PERM = true, AFTER_DRAIN = false;
    bf16_t* O; int ldc;
    __device__ __forceinline__ void operator()(const f32x4 (&acc)[2][2][4][2], const pg8::Unit& u, int wr, int wc, int fr, int fq) const {
        const int row0 = u.pm * 256 + wr * 64 + fr, col0 = u.pn * 256 + wc * 32 + 8 * fq;
#pragma unroll
        for (int ai = 0; ai < 2; ++ai)
#pragma unroll
            for (int m = 0; m < 4; ++m) { bf16_t* rowp = O + (size_t)(row0 + ai * 128 + m * 16) * ldc + col0;
#pragma unroll
                for (int bj = 0; bj < 2; ++bj) { const f32x4 v0 = acc[ai][bj][m][0], v1 = acc[ai][bj][m][1];
                    u32x4 w; w.x = cvt_pk_bf16(v0[0], v0[1]); w.y = cvt_pk_bf16(v0[2], v0[3]); w.z = cvt_pk_bf16(v1[0], v1[1]); w.w = cvt_pk_bf16(v1[2], v1[3]);
                    *(u32x4*)(rowp + bj * 128) = w; } }
    }
};
struct EpiResid {
    static constexpr bool PERM = false, AFTER_DRAIN = false;
    const float* xin_p; const float* xin_s; float* xout; const float* gate;
    __device__ __forceinline__ void operator()(const f32x4 (&acc)[2][2][4][2], const pg8::Unit& u, int wr, int wc, int fr, int fq) const {
        const int row0 = u.pm * 256 + wr * 64 + fr, col0 = u.pn * 256 + wc * 32 + 4 * fq;
        const float* gp = gate + (size_t)cond_of_row(u.pm * 256) * 12288 + col0;
        f32x4 gv[2][2];
#pragma unroll
        for (int bj = 0; bj < 2; ++bj)
#pragma unroll
            for (int n = 0; n < 2; ++n) gv[bj][n] = *(const f32x4*)(gp + bj * 128 + n * 16);
#pragma unroll
        for (int ai = 0; ai < 2; ++ai) { f32x4 xi[4][2][2];
#pragma unroll
            for (int m = 0; m < 4; ++m) { const int row = row0 + ai * 128 + m * 16;
                const float* ip = (row < NP ? xin_p + (size_t)row * D : xin_s + (size_t)(row - NP) * D) + col0;
#pragma unroll
                for (int bj = 0; bj < 2; ++bj)
#pragma unroll
                    for (int n = 0; n < 2; ++n) xi[m][bj][n] = *(const f32x4*)(ip + bj * 128 + n * 16); }
            asm volatile("" ::: "memory");
#pragma unroll
            for (int m = 0; m < 4; ++m) { const int row = row0 + ai * 128 + m * 16; float* op = xout + (size_t)row * D + col0;
#pragma unroll
                for (int bj = 0; bj < 2; ++bj)
#pragma unroll
                    for (int n = 0; n < 2; ++n) *(f32x4*)(op + bj * 128 + n * 16) = xi[m][bj][n] + gv[bj][n] * acc[ai][bj][m][n]; } }
    }
};

DI void tr_tile_wave(const float* src, bf16_t* dst, int K, int N, int k0, int n0, LAS float* ts, int lane) {
    const int ty = lane >> 4, tx = lane & 15;
    f32x4 v[16];
#pragma unroll
    for (int i = 0; i < 16; ++i) v[i] = *(const f32x4*)(src + (size_t)(k0 + ty + 4 * i) * N + n0 + 4 * tx);
#pragma unroll
    for (int i = 0; i < 16; ++i) { const int k = ty + 4 * i; ts[k * 65 + 4 * tx + 0] = v[i][0]; ts[k * 65 + 4 * tx + 1] = v[i][1]; ts[k * 65 + 4 * tx + 2] = v[i][2]; ts[k * 65 + 4 * tx + 3] = v[i][3]; }
    __builtin_amdgcn_fence(__ATOMIC_ACQ_REL, "wavefront"); __builtin_amdgcn_wave_barrier();
    const int nl = lane >> 3, kc = (lane & 7) * 8;
#pragma unroll
    for (int g = 0; g < 8; ++g) { const int n = 8 * g + nl; float w[8];
#pragma unroll
        for (int j = 0; j < 8; ++j) w[j] = ts[(kc + j) * 65 + n];
        u32x4 pk; pk.x = cvt_pk_bf16(w[0], w[1]); pk.y = cvt_pk_bf16(w[2], w[3]); pk.z = cvt_pk_bf16(w[4], w[5]); pk.w = cvt_pk_bf16(w[6], w[7]);
        *(u32x4*)(dst + (size_t)(n0 + n) * K + k0 + kc) = pk; }
    __builtin_amdgcn_fence(__ATOMIC_ACQ_REL, "wavefront"); __builtin_amdgcn_wave_barrier();
}
DI void cvt_range(const float* src, bf16_t* dst, size_t n8, size_t gtid, size_t gstride) {
    for (size_t i = gtid; i < n8; i += gstride) { const f32x4 a = *(const f32x4*)(src + i * 8), b = *(const f32x4*)(src + i * 8 + 4);
        u32x4 w; w.x = cvt_pk_bf16(a[0], a[1]); w.y = cvt_pk_bf16(a[2], a[3]); w.z = cvt_pk_bf16(b[0], b[1]); w.w = cvt_pk_bf16(b[2], b[3]); *(u32x4*)(dst + i * 8) = w; }
}
DI void mod_unit(const Params& p, int u, LAS float* sl) {
    const int tid = threadIdx.x, lane = tid & 63, wave = tid >> 6;
    const int l = u / 384, cb = (u % 384) * 32, cl = tid & 7, ks = tid >> 3;
    for (int i = tid; i < 9 * 2048; i += NTHR) { const int c = i >> 11, k = i & 2047; const float v = (c == 0) ? p.c_ctx[k] : p.c[(c - 1) * 2048 + k]; sl[i] = v / (1.f + __expf(-v)); }
    __syncthreads();
    const float* W = p.w_mod + (size_t)l * 2048 * 12288 + cb + 4 * cl;
    float acc[9][4];
#pragma unroll
    for (int c = 0; c < 9; ++c)
#pragma unroll
        for (int j = 0; j < 4; ++j) acc[c][j] = 0.f;
#pragma unroll 4
    for (int kk = 0; kk < 32; ++kk) { const int k = kk * 64 + ks; const f32x4 w = *(const f32x4*)(W + (size_t)k * 12288);
#pragma unroll
        for (int c = 0; c < 9; ++c) { const float s = sl[c * 2048 + k];
#pragma unroll
            for (int j = 0; j < 4; ++j) acc[c][j] += s * w[j]; } }
#pragma unroll
    for (int c = 0; c < 9; ++c)
#pragma unroll
        for (int j = 0; j < 4; ++j) { float v = acc[c][j]; v += __shfl_xor(v, 8); v += __shfl_xor(v, 16); v += __shfl_xor(v, 32); acc[c][j] = v; }
    __syncthreads();
    LAS float* red = sl;
    if (lane < 8) {
#pragma unroll
        for (int c = 0; c < 9; ++c)
#pragma unroll
            for (int j = 0; j < 4; ++j) red[(wave * 9 + c) * 32 + cl * 4 + j] = acc[c][j]; }
    __syncthreads();
    if (tid < 288) { const int c = tid >> 5, col = tid & 31; float s = 0.f;
#pragma unroll
        for (int w = 0; w < 8; ++w) s += red[(w * 9 + c) * 32 + col];
        float* mod = (float*)(p.ws + WS_MOD);
        mod[(size_t)(l * 9 + c) * 12288 + cb + col] = s + p.b_mod[(size_t)l * 12288 + cb + col]; }
    __syncthreads();
}
constexpr int TR_T0 = 2560, TR_T1 = TR_T0 + 1024, TR_T2 = TR_T1 + 3072, TR_T3 = TR_T2 + 1024, TR_T4 = TR_T3 + 1024, TR_T5 = TR_T4 + 1024, TR_T6 = TR_T5 + 128;
constexpr int PRO_UNITS = TR_T6 + 768;

DI void prologue_phase(const Params& p, LAS unsigned char* lds) {
    const int tid = threadIdx.x;
    unsigned char* ws = p.ws;
    if (blockIdx.x == 0) {
        float* rope = (float*)(ws + WS_ROPE);
        for (int i = tid; i < 1024; i += NTHR) { const int pos = i >> 4, f = i & 15; const float inv = powf(10000.f, -(float)f / 16.f); const float ang = (float)pos * inv; rope[2 * i] = cosf(ang); rope[2 * i + 1] = sinf(ang); }
        if (tid < 64) { const float* lp = p.a_lambda; float a = lp[tid] * lp[64 + tid], b = lp[128 + tid] * lp[192 + tid]; a = wave_sum(a); b = wave_sum(b);
            if (tid == 0) ((float*)(ws + WS_SCAL))[0] = expf(a) - expf(b) + 0.2f; }
    }
    { const int lane = tid & 63, wave = tid >> 6;
      for (int u = blockIdx.x * NWAVES + wave; u < TR_T6; u += gridDim.x * NWAVES) {
          const float* src; bf16_t* dst; int K = 2048, N, t;
          if (u < TR_T0) { src = p.even_w_in; dst = (bf16_t*)(ws + WS_WEI); N = EVEN_IN; t = u; }
          else if (u < TR_T1) { src = p.even_w_out; dst = (bf16_t*)(ws + WS_WEO); N = D; t = u - TR_T0; }
          else if (u < TR_T2) { src = p.odd_w_in; dst = (bf16_t*)(ws + WS_WOI); N = ODD_IN; t = u - TR_T1; }
          else if (u < TR_T3) { src = p.odd_w_out; dst = (bf16_t*)(ws + WS_WOO); N = D; t = u - TR_T2; }
          else if (u < TR_T4) { src = p.peer_w_q; dst = (bf16_t*)(ws + WS_WPQ); N = D; t = u - TR_T3; }
          else if (u < TR_T5) { src = p.peer_w_q + (size_t)D * D; dst = (bf16_t*)(ws + WS_WPQ) + (size_t)D * D; N = D; t = u - TR_T4; }
          else { t = u - TR_T5; const int mat = t >> 2; t &= 3; const int kind = mat >> 4, rest = mat & 15;
              src = (kind ? p.lru_w_i : p.lru_w_a) + (size_t)rest * 128 * 128; dst = (bf16_t*)(ws + WS_LRW) + (size_t)mat * 128 * 128; K = 128; N = 128; }
          const int ntn = N / 64; const int tk = t / ntn, tn = t % ntn;
          tr_tile_wave(src, dst, K, N, tk * 64, tn * 64, (LAS float*)lds + wave * (64 * 65), lane);
      } }
    __syncthreads();
    for (int u = blockIdx.x; u < PRO_UNITS - TR_T6; u += gridDim.x) mod_unit(p, u, (LAS float*)lds);
    const size_t gtid = (size_t)blockIdx.x * NTHR + tid, gstride = (size_t)gridDim.x * NTHR;
    cvt_range(p.peer_sub_keys, (bf16_t*)(ws + WS_SK), (size_t)2 * 8 * 2 * 128 * 128 / 8, gtid, gstride);
    cvt_range(p.cache_a_k, (bf16_t*)(ws + WS_CAK), (size_t)8 * 512 * 1024 / 8, gtid, gstride);
    cvt_range(p.cache_a_v, (bf16_t*)(ws + WS_CAV), (size_t)8 * 512 * 1024 / 8, gtid, gstride);
    cvt_range(p.cache_c_k, (bf16_t*)(ws + WS_CCK), (size_t)8 * 512 * 2048 / 8, gtid, gstride);
    cvt_range(p.cache_c_v, (bf16_t*)(ws + WS_CCV), (size_t)8 * 512 * 2048 / 8, gtid, gstride);
    { const int lane = tid & 63, wave = tid >> 6;
      bool interleaved;
      { f32x16 pa, pb;
#pragma unroll
        for (int i = 0; i < 16; ++i) { pa[i] = 0.125f * (float)i; pb[i] = i < 8 ? 2.f + 0.25f * (float)i : 4.f + 0.5f * (float)(i - 8); }
        const f32x32 d = __builtin_amdgcn_cvt_scalef32_pk32_f32_fp6(__builtin_amdgcn_cvt_scalef32_2xpk16_fp6_f32(pa, pb, 1.0f), 1.0f);
        interleaved = (d[1] != 0.125f); }
      for (int rw = blockIdx.x * NWAVES + wave; rw < 4 * PEER_N; rw += gridDim.x * NWAVES) {
          const int tbl = rw >> 15, r = rw & 32767;
          const float* src = (tbl ? p.peer_v : p.peer_u) + (size_t)r * D + 32 * lane;
          f32x4 x[8]; float am = 0.f;
#pragma unroll
          for (int q = 0; q < 8; ++q) { x[q] = *(const f32x4*)(src + 4 * q);
#pragma unroll
              for (int j = 0; j < 4; ++j) am = fmaxf(am, fabsf(x[q][j])); }
          am = fmaxf(am, __shfl_xor(am, 1)); am = fmaxf(am, __shfl_xor(am, 2)); am = fmaxf(am, __shfl_xor(am, 4)); am = fmaxf(am, __shfl_xor(am, 8)); am = fmaxf(am, __shfl_xor(am, 16)); am = fmaxf(am, __shfl_xor(am, 32));
          const float inv = am > 0.f ? 7.5f / am : 0.f;
          f32x16 a, b;
          if (!interleaved) {
#pragma unroll
              for (int i = 0; i < 16; ++i) { a[i] = x[i >> 2][i & 3] * inv; b[i] = x[4 + (i >> 2)][i & 3] * inv; }
          } else {
#pragma unroll
              for (int i = 0; i < 16; ++i) { a[i] = x[(2 * i) >> 2][(2 * i) & 3] * inv; b[i] = x[(2 * i + 1) >> 2][(2 * i + 1) & 3] * inv; }
          }
          const u32x6 pk = __builtin_amdgcn_cvt_scalef32_2xpk16_fp6_f32(a, b, 1.0f);
          unsigned char* dst = ws + (tbl ? WS_PV : WS_PU) + (size_t)r * PROW + 24 * lane;
          *(u32x2*)dst = (u32x2){pk[0], pk[1]}; *(u32x2*)(dst + 8) = (u32x2){pk[2], pk[3]}; *(u32x2*)(dst + 16) = (u32x2){pk[4], pk[5]};
          if (lane == 0) ((float*)(ws + (tbl ? WS_PSV : WS_PSU)))[r] = am > 0.f ? am * (1.f / 7.5f) : 1.f;
      } }
}

DI void norm_row_store(const f32x4 (&x)[4][2], const float* g, const float* shift, const float* scale, bf16_t* hrow, int lane) {
    float ss = 0.f;
#pragma unroll
    for (int k = 0; k < 4; ++k)
#pragma unroll
        for (int q = 0; q < 2; ++q)
#pragma unroll
            for (int j = 0; j < 4; ++j) ss += x[k][q][j] * x[k][q][j];
    ss = wave_sum(ss);
    const float rs = rsqrtf(ss * (1.f / 2048.f) + 1e-6f);
#pragma unroll
    for (int k = 0; k < 4; ++k) { const int e = 512 * k + 8 * lane; float y[8];
#pragma unroll
        for (int q = 0; q < 2; ++q) { const f32x4 gv = *(const f32x4*)(g + e + 4 * q), sc = *(const f32x4*)(scale + e + 4 * q), sh = *(const f32x4*)(shift + e + 4 * q);
#pragma unroll
            for (int j = 0; j < 4; ++j) y[4 * q + j] = x[k][q][j] * rs * gv[j] * (1.f + sc[j]) + sh[j]; }
        u32x4 w; w.x = cvt_pk_bf16(y[0], y[1]); w.y = cvt_pk_bf16(y[2], y[3]); w.z = cvt_pk_bf16(y[4], y[5]); w.w = cvt_pk_bf16(y[6], y[7]);
        *(u32x4*)(hrow + e) = w; }
}
template <bool FIRST> DI void norm_phase(const Params& p, int l, int which) {
    const int tid = threadIdx.x, lane = tid & 63, wave = tid >> 6;
    const float* mod = (const float*)(p.ws + WS_MOD) + (size_t)l * 9 * 12288;
    const float* g = (which ? p.norm2_g : p.norm1_g) + l * D;
    bf16_t* h = (bf16_t*)(p.ws + WS_H);
    const float* xres = p.out + OUT_YP;
    constexpr int RPW = NTOK / (256 * NWAVES);
    int cached = -1; f32x4 gs[4][2], sh[4][2];
    for (int gw = blockIdx.x * NWAVES + wave; gw * RPW < NTOK; gw += gridDim.x * NWAVES)
        for (int i = 0; i < RPW; ++i) { const int row = gw * RPW + i;
            const float* xr = FIRST ? (row < NP ? p.x_prompt + (size_t)row * D : p.x_sample + (size_t)(row - NP) * D) : xres + (size_t)row * D;
            f32x4 x[4][2];
#pragma unroll
            for (int k = 0; k < 4; ++k)
#pragma unroll
                for (int q = 0; q < 2; ++q) x[k][q] = *(const f32x4*)(xr + 512 * k + 8 * lane + 4 * q);
            const int cond = cond_of_row(row);
            if (cond != cached) { cached = cond; const float* mc = mod + (size_t)cond * 12288 + which * 3 * D;
#pragma unroll
                for (int k = 0; k < 4; ++k)
#pragma unroll
                    for (int q = 0; q < 2; ++q) { const int e = 512 * k + 8 * lane + 4 * q; const f32x4 gv = *(const f32x4*)(g + e), sc = *(const f32x4*)(mc + D + e); sh[k][q] = *(const f32x4*)(mc + e);
#pragma unroll
                        for (int j = 0; j < 4; ++j) gs[k][q][j] = gv[j] * (1.f + sc[j]); } }
            float ss = 0.f;
#pragma unroll
            for (int k = 0; k < 4; ++k)
#pragma unroll
                for (int q = 0; q < 2; ++q)
#pragma unroll
                    for (int j = 0; j < 4; ++j) ss += x[k][q][j] * x[k][q][j];
            ss = wave_sum(ss);
            const float rs = rsqrtf(ss * (1.f / 2048.f) + 1e-6f);
#pragma unroll
            for (int k = 0; k < 4; ++k) { float y[8];
#pragma unroll
                for (int q = 0; q < 2; ++q)
#pragma unroll
                    for (int j = 0; j < 4; ++j) y[4 * q + j] = x[k][q][j] * rs * gs[k][q][j] + sh[k][q][j];
                u32x4 w; w.x = cvt_pk_bf16(y[0], y[1]); w.y = cvt_pk_bf16(y[2], y[3]); w.z = cvt_pk_bf16(y[4], y[5]); w.w = cvt_pk_bf16(y[6], y[7]);
                *(u32x4*)(h + (size_t)row * D + 512 * k + 8 * lane) = w; }
        }
}

constexpr int KT_BYTES = 16384, VT_BYTES = 16384, ATT_BUF = KT_BYTES + VT_BYTES;
constexpr int ATT_RPB = 2 * ATT_BUF;
#define MFMA32(a, b, c) __builtin_amdgcn_mfma_f32_32x32x16_bf16((a), (b), (c), 0, 0, 0)
struct AttnArgs {
    const bf16_t* Q; int ldq;
    const bf16_t* K0; const bf16_t* V0; int n0, ld0;
    const bf16_t* K1; const bf16_t* V1; int n1, ld1;
    bf16_t* O; int ldo;
    float C;
    float lam; const float* subg;
    const float* rpb; int qr0, krlo;
};
DI void att_dma(const AttnArgs& a, int j, LAS unsigned char* buf, int wave, int lane) {
    int key0 = j * 64; const bf16_t* K = a.K0; const bf16_t* V = a.V0; int ld = a.ld0;
    if (key0 >= a.n0) { key0 -= a.n0; K = a.K1; V = a.V1; ld = a.ld1; }
    const int sub = lane >> 5, rr = (lane >> 2) & 7, cp = lane & 3;
#pragma unroll
    for (int i = 0; i < 2; ++i) { const int pc = 2 * wave + i, R = pc >> 1, Cp = pc & 1;
        const int row = 8 * R + rr, ch = 4 * (2 * Cp + sub) + (cp ^ ((2 * R + (rr >> 2)) & 3));
        const size_t off = (size_t)(key0 + row) * ld + ch * 8;
        __builtin_amdgcn_global_load_lds((const unsigned*)(K + off), (LAS unsigned*)(buf + pc * 1024), 16, 0, 0);
        __builtin_amdgcn_global_load_lds((const unsigned*)(V + off), (LAS unsigned*)(buf + KT_BYTES + pc * 1024), 16, 0, 0); }
}
DI bf16x8 pack8(const f32x16& x, int s) {
    u32x4 w; w.x = cvt_pk_bf16(x[8 * s + 0], x[8 * s + 1]); w.y = cvt_pk_bf16(x[8 * s + 2], x[8 * s + 3]); w.z = cvt_pk_bf16(x[8 * s + 4], x[8 * s + 5]); w.w = cvt_pk_bf16(x[8 * s + 6], x[8 * s + 7]);
    return __builtin_bit_cast(bf16x8, w);
}
template <int MODE> DI void attn_unit(LAS unsigned char* lds, const AttnArgs& a) {
    const int tid = threadIdx.x, lane = tid & 63, wave = __builtin_amdgcn_readfirstlane(tid >> 6), r = lane & 31, h = lane >> 5;
    constexpr int NKS = MODE == 0 ? 4 : 8;
    const int qloc = MODE == 0 ? 32 * (wave >> 1) + r : 32 * wave + r;
    const int kofs = MODE == 0 ? 64 * (wave & 1) : 0;
    bf16x8 qf[NKS];
    { const bf16_t* qp = a.Q + (size_t)qloc * a.ldq + kofs + 8 * h;
#pragma unroll
      for (int ks = 0; ks < NKS; ++ks) qf[ks] = *(const bf16x8*)(qp + 16 * ks); }
    if (MODE == 2) { for (int i = tid; i < 465; i += NTHR) ((LAS float*)(lds + ATT_RPB))[i] = a.rpb[i] * 1.4426950408889634f; }
    f32x16 o[4];
#pragma unroll
    for (int d4 = 0; d4 < 4; ++d4)
#pragma unroll
        for (int i = 0; i < 16; ++i) o[d4][i] = 0.f;
    float m = -1e30f, l = 0.f;
    const int ntiles = (a.n0 + a.n1) >> 6;
    att_dma(a, 0, lds, wave, lane);
    asm volatile("s_waitcnt vmcnt(0)" ::: "memory");
    __syncthreads();
    int qr = 0, qc = 0, cs = 0, rs = 0;
    if (MODE == 2) { qr = a.qr0 + (wave >> 1); qc = 32 * (wave & 1) + r; cs = min(max(qc - 8, 0), 48); rs = min(max(qr - 4, 0), 56); }
    const int kb0 = 2048 * (r >> 3) + 64 * (r & 7) + 512 * (kofs >> 5);
    const int kbase0 = kb0 + 16 * ((0 + h) ^ ((r >> 2) & 3)), kbase1 = kb0 + 16 * ((2 + h) ^ ((r >> 2) & 3));
    const int tblk = (lane >> 4) & 1, tq = (lane & 15) >> 2, tp = lane & 3;
    const int vb0 = 64 * (4 * h + tq) + 8 * (tp & 1);
    const int vbase0 = vb0 + 16 * ((2 * tblk + (tp >> 1)) ^ ((0 + h) & 3)), vbase1 = vb0 + 2048 + 16 * ((2 * tblk + (tp >> 1)) ^ ((2 + h) & 3));
    for (int j = 0; j < ntiles; ++j) {
        LAS unsigned char* buf = lds + (j & 1) * ATT_BUF;
        if (j + 1 < ntiles) att_dma(a, j + 1, lds + ((j + 1) & 1) * ATT_BUF, wave, lane);
        bool active = true; int kr = 0;
        if (MODE == 2 && j >= 8) { kr = a.krlo + (j - 8); const int wrs = min(max(a.qr0 + (wave >> 1) - 4, 0), 56); active = (kr >= wrs) && (kr < wrs + 8); }
        if (active) {
            f32x16 s0, s1;
#pragma unroll
            for (int i = 0; i < 16; ++i) { s0[i] = 0.f; s1[i] = 0.f; }
#pragma unroll
            for (int ks = 0; ks < NKS; ++ks) { const LAS unsigned char* kp = buf + ((ks & 1) ? kbase1 : kbase0) + 512 * (ks >> 1);
                const bf16x8 k0 = *(const LAS bf16x8*)kp, k1 = *(const LAS bf16x8*)(kp + 8192);
                s0 = MFMA32(k0, qf[ks], s0); s1 = MFMA32(k1, qf[ks], s1); }
            if (MODE == 2) {
#pragma unroll
                for (int i = 0; i < 16; ++i) { s0[i] *= a.C; s1[i] *= a.C; }
                if (j >= 8) {
                    const LAS float* rp = (const LAS float*)(lds + ATT_RPB) + (kr - qr + 7) * 31 + 15 - qc;
#pragma unroll
                    for (int i = 0; i < 16; ++i) { const int kc = (i & 3) + 8 * (i >> 2) + 4 * h;
                        s0[i] = (kc >= cs && kc < cs + 16) ? s0[i] + rp[kc] : -INFINITY;
                        s1[i] = (kc + 32 >= cs && kc + 32 < cs + 16) ? s1[i] + rp[kc + 32] : -INFINITY; }
                }
            }
            const float Ce = MODE == 2 ? 1.f : a.C;
            float mx = fmaxf(s0[0], s1[0]);
#pragma unroll
            for (int i = 1; i < 16; ++i) mx = fmaxf(mx, fmaxf(s0[i], s1[i]));
            mx = fmaxf(mx, __shfl_xor(mx, 32)) * Ce;
            if (!__all(mx <= m + 8.f)) {
                const float mn = fmaxf(m, mx), alpha = __builtin_amdgcn_exp2f(m - mn); m = mn; l *= alpha;
#pragma unroll
                for (int d4 = 0; d4 < 4; ++d4)
#pragma unroll
                    for (int i = 0; i < 16; ++i) o[d4][i] *= alpha;
            }
            float ps = 0.f;
#pragma unroll
            for (int i = 0; i < 16; ++i) { s0[i] = __builtin_amdgcn_exp2f(fmaf(s0[i], Ce, -m)); s1[i] = __builtin_amdgcn_exp2f(fmaf(s1[i], Ce, -m)); ps += s0[i] + s1[i]; }
            l += ps;
            bf16x8 pf[4]; pf[0] = pack8(s0, 0); pf[1] = pack8(s0, 1); pf[2] = pack8(s1, 0); pf[3] = pack8(s1, 1);
            const LAS unsigned char* vp0 = buf + KT_BYTES + vbase0; const LAS unsigned char* vp1 = buf + KT_BYTES + vbase1;
#pragma unroll
            for (int kk = 0; kk < 4; ++kk)
#pragma unroll
                for (int d4 = 0; d4 < 4; ++d4) {
                    const s16x4 lo = __builtin_amdgcn_ds_read_tr16_b64_v4i16((LAS s16x4*)(vp0 + 4096 * kk + 512 * d4));
                    const s16x4 hi = __builtin_amdgcn_ds_read_tr16_b64_v4i16((LAS s16x4*)(vp1 + 4096 * kk + 512 * d4));
                    bf16x8 vf; vf[0] = lo[0]; vf[1] = lo[1]; vf[2] = lo[2]; vf[3] = lo[3]; vf[4] = hi[0]; vf[5] = hi[1]; vf[6] = hi[2]; vf[7] = hi[3];
                    o[d4] = MFMA32(vf, pf[kk], o[d4]);
                }
        }
        asm volatile("s_waitcnt vmcnt(0)" ::: "memory");
        __syncthreads();
    }
    l += __shfl_xor(l, 32);
    const float inv = 1.f / l;
    if (MODE != 0) {
        bf16_t* op = a.O + (size_t)qloc * a.ldo + 4 * h;
#pragma unroll
        for (int d4 = 0; d4 < 4; ++d4)
#pragma unroll
            for (int g4 = 0; g4 < 4; ++g4) { u32x2 w; w.x = cvt_pk_bf16(o[d4][4 * g4] * inv, o[d4][4 * g4 + 1] * inv); w.y = cvt_pk_bf16(o[d4][4 * g4 + 2] * inv, o[d4][4 * g4 + 3] * inv);
                *(u32x2*)(op + 32 * d4 + 8 * g4) = w; }
    } else {
        LAS float* ex = (LAS float*)lds + qloc * 132 + 4 * h;
        if (wave & 1) {
#pragma unroll
            for (int d4 = 0; d4 < 4; ++d4)
#pragma unroll
                for (int g4 = 0; g4 < 4; ++g4) { f32x4 v; v[0] = o[d4][4 * g4] * inv; v[1] = o[d4][4 * g4 + 1] * inv; v[2] = o[d4][4 * g4 + 2] * inv; v[3] = o[d4][4 * g4 + 3] * inv; *(LAS f32x4*)(ex + 32 * d4 + 8 * g4) = v; }
        }
        __syncthreads();
        if (!(wave & 1)) {
            float ss = 0.f;
#pragma unroll
            for (int d4 = 0; d4 < 4; ++d4)
#pragma unroll
                for (int g4 = 0; g4 < 4; ++g4) { const f32x4 o1 = *(const LAS f32x4*)(ex + 32 * d4 + 8 * g4);
#pragma unroll
                    for (int e = 0; e < 4; ++e) { const float v = o[d4][4 * g4 + e] * inv - a.lam * o1[e]; o[d4][4 * g4 + e] = v; ss += v * v; } }
            ss += __shfl_xor(ss, 32);
            const float rsn = rsqrtf(ss * (1.f / 128.f) + 1e-6f) * 0.8f;
            bf16_t* op = a.O + (size_t)qloc * a.ldo + 4 * h;
#pragma unroll
            for (int d4 = 0; d4 < 4; ++d4)
#pragma unroll
                for (int g4 = 0; g4 < 4; ++g4) { const f32x4 gv = *(const f32x4*)(a.subg + 32 * d4 + 8 * g4 + 4 * h);
                    u32x2 w; w.x = cvt_pk_bf16(o[d4][4 * g4] * rsn * gv[0], o[d4][4 * g4 + 1] * rsn * gv[1]); w.y = cvt_pk_bf16(o[d4][4 * g4 + 2] * rsn * gv[2], o[d4][4 * g4 + 3] * rsn * gv[3]);
                    *(u32x2*)(op + 32 * d4 + 8 * g4) = w; }
        }
        __syncthreads();
    }
}
DI int q_next(unsigned* ctr, volatile LAS unsigned* misc) {
    __syncthreads();
    if (threadIdx.x == 0) misc[0] = __hip_atomic_fetch_add(ctr, 1u, __ATOMIC_RELAXED, __HIP_MEMORY_SCOPE_AGENT);
    __syncthreads();
    return (int)misc[0];
}

constexpr int LR_W = 0;
constexpr int LR_WK = 128 * 272;
constexpr int LR_XR = LR_W + 2 * LR_WK;
constexpr int LR_XCB = LR_XR + 9216;
constexpr int LR_XC = LR_XCB + 32 * 272;
constexpr int LR_AS = LR_XC + 32 * 132 * 4;
constexpr int LR_BS = LR_AS + 32 * 144 * 4;
constexpr int LR_CAR = LR_BS + 32 * 144 * 4;
constexpr int LR_HC = LR_CAR + 4 * 128 * 8;
constexpr int LR_END = LR_HC + 512;
static_assert(LR_END <= LDS_MISC, "LRU LDS map");
#define MFMA16(a, b, c) __builtin_amdgcn_mfma_f32_16x16x32_bf16((a), (b), (c), 0, 0, 0)

DI float fast_sigmoid(float x) { return __builtin_amdgcn_rcpf(1.f + __builtin_amdgcn_exp2f(-1.4426950408889634f * x)); }
DI void lru_unit(const Params& p, LAS unsigned char* lds, int seq, int blk) {
    const int tid = threadIdx.x, lane = tid & 63, wave = __builtin_amdgcn_readfirstlane(tid >> 6);
    const int T = seq < 32 ? TP : TS, tb = seq < 32 ? seq * TP : NP + (seq - 32) * TS, c0 = blk * 128;
    const bf16_t* proj = (const bf16_t*)(p.ws + WS_PROJ);
    float* HF = (float*)(p.ws + WS_H);
    bf16_t* mix = (bf16_t*)(p.ws + WS_MIX);
    const bf16_t* lrw = (const bf16_t*)(p.ws + WS_LRW);
    const int c = tid & 127, sub = tid >> 7;
    float cw[4];
#pragma unroll
    for (int j = 0; j < 4; ++j) cw[j] = p.lru_conv_w[j * 1024 + c0 + c];
    const float cb = p.lru_conv_b[c0 + c];
    const int tbk = wave & 1, cg = wave >> 1, fr = lane & 15, fq = lane >> 4;
    LAS float* HC = (LAS float*)(lds + LR_HC);
    for (int dir = 0; dir < 2; ++dir) {
        __syncthreads();
#pragma unroll
        for (int i = 0; i < 8; ++i) { const int ch = tid + 512 * i, kind = ch >> 11, rem = ch & 2047, o = rem >> 4, cc = rem & 15;
            const u32x4 w = *(const u32x4*)(lrw + ((size_t)((kind * 2 + dir) * 8 + blk) * 128 + o) * 128 + cc * 8);
            *(LAS u32x4*)(lds + LR_W + kind * LR_WK + o * 272 + cc * 16) = w; }
        float ba[2], bi[2], nsp[2];
#pragma unroll
        for (int cbk = 0; cbk < 2; ++cbk) { const int o = c0 + 32 * cg + 16 * cbk + fr; ba[cbk] = p.lru_b_a[dir * 1024 + o]; bi[cbk] = p.lru_b_i[dir * 1024 + o];
            const float lam = p.lru_lambda[dir * 1024 + o]; const float sp = (-lam > 20.f) ? -lam : log1pf(__expf(-lam)); nsp[cbk] = -8.f * sp * 1.4426950408889634f; }
        if (tid < 128) HC[tid] = (seq >= 32) ? p.state_lru[(size_t)(seq - 32) * 2048 + dir * 1024 + c0 + tid] : 0.f;
        const int nch = T / 32;
        u32x4 xrn[2];
        auto ld_xr = [&](int t0) {
#pragma unroll
            for (int i = 0; i < 2; ++i) { const int ch = tid + 512 * i, row = ch >> 4, cc = ch & 15, t = t0 - 2 + row; u32x4 v = {0u, 0u, 0u, 0u};
                if (ch < 560 && t >= 0 && t < T) v = *(const u32x4*)(proj + (size_t)(tb + t) * EVEN_IN + 3072 + c0 + cc * 8);
                xrn[i] = v; } };
        ld_xr(dir ? T - 32 : 0);
        for (int chk = 0; chk < nch; ++chk) {
            const int t0 = dir ? T - 32 - 32 * chk : 32 * chk;
#pragma unroll
            for (int i = 0; i < 2; ++i) { const int ch = tid + 512 * i; if (ch < 560) *(LAS u32x4*)(lds + LR_XR + ch * 16) = xrn[i]; }
            if (chk + 1 < nch) ld_xr(dir ? t0 - 32 : t0 + 32);
            float hfv[8]; unsigned short gv[8];
            if (dir) {
#pragma unroll
                for (int i = 0; i < 8; ++i) { const int tl = 31 - (8 * sub + i); const size_t tok = (size_t)(tb + t0 + tl);
                    hfv[i] = HF[tok * 1024 + c0 + c]; gv[i] = proj[tok * EVEN_IN + 4096 + c0 + c]; } }
            __syncthreads();
            { const LAS bf16_t* xr = (const LAS bf16_t*)(lds + LR_XR);
#pragma unroll
              for (int i = 0; i < 8; ++i) { const int tl = 8 * sub + i; float acc = cb;
#pragma unroll
                  for (int j = 0; j < 4; ++j) acc += cw[j] * __uint_as_float(((unsigned)xr[(tl + j) * 128 + c]) << 16);
                  ((LAS float*)(lds + LR_XC))[tl * 132 + c] = acc;
                  ((LAS bf16_t*)(lds + LR_XCB))[tl * 136 + c] = (bf16_t)(cvt_pk_bf16(acc, 0.f) & 0xffffu); } }
            __syncthreads();
            { f32x4 acc[2][2];
#pragma unroll
              for (int k = 0; k < 2; ++k)
#pragma unroll
                  for (int cbk = 0; cbk < 2; ++cbk) acc[k][cbk] = (f32x4){0.f, 0.f, 0.f, 0.f};
#pragma unroll
              for (int ks = 0; ks < 4; ++ks) { const bf16x8 af = *(const LAS bf16x8*)(lds + LR_XCB + (16 * tbk + fr) * 272 + (32 * ks + 8 * fq) * 2);
#pragma unroll
                  for (int k = 0; k < 2; ++k)
#pragma unroll
                      for (int cbk = 0; cbk < 2; ++cbk) { const bf16x8 bf = *(const LAS bf16x8*)(lds + LR_W + k * LR_WK + (32 * cg + 16 * cbk + fr) * 272 + (32 * ks + 8 * fq) * 2);
                          acc[k][cbk] = MFMA16(af, bf, acc[k][cbk]); } }
#pragma unroll
              for (int cbk = 0; cbk < 2; ++cbk)
#pragma unroll
                  for (int rg = 0; rg < 4; ++rg) { const int tl = 16 * tbk + 4 * fq + rg, o = 32 * cg + 16 * cbk + fr;
                      const float rr = fast_sigmoid(acc[0][cbk][rg] + ba[cbk]), ii = fast_sigmoid(acc[1][cbk][rg] + bi[cbk]);
                      const float la = rr * nsp[cbk], av = __builtin_amdgcn_exp2f(la), xc = ((const LAS float*)(lds + LR_XC))[tl * 132 + o];
                      const float bv = __builtin_amdgcn_sqrtf(fmaxf((1.f - av) * (1.f + av), 0.f)) * ii * xc;
                      ((LAS float*)(lds + LR_AS))[tl * 144 + o] = av; ((LAS float*)(lds + LR_BS))[tl * 144 + o] = bv; } }
            __syncthreads();
            float hl[8], Pv[8];
            { float hh = 0.f, P = 1.f;
#pragma unroll
              for (int i = 0; i < 8; ++i) { const int u = 8 * sub + i, tl = dir ? 31 - u : u; const float av = ((const LAS float*)(lds + LR_AS))[tl * 144 + c], bv = ((const LAS float*)(lds + LR_BS))[tl * 144 + c];
                  hh = av * hh + bv; P *= av; hl[i] = hh; Pv[i] = P; }
              *(LAS f32x2*)(lds + LR_CAR + (sub * 128 + c) * 8) = (f32x2){P, hh}; }
            __syncthreads();
            float hin = HC[c];
#pragma unroll
            for (int s = 0; s < 3; ++s) if (s < sub) { const f32x2 e = *(const LAS f32x2*)(lds + LR_CAR + (s * 128 + c) * 8); hin = e[0] * hin + e[1]; }
            float hv[8];
#pragma unroll
            for (int i = 0; i < 8; ++i) hv[i] = hl[i] + Pv[i] * hin;
            __syncthreads();
            if (sub == 3) HC[c] = hv[7];
            if (!dir) {
#pragma unroll
                for (int i = 0; i < 8; ++i) { const int tl = 8 * sub + i; HF[(size_t)(tb + t0 + tl) * 1024 + c0 + c] = hv[i]; }
            } else {
#pragma unroll
                for (int i = 0; i < 8; ++i) { const int tl = 31 - (8 * sub + i); const float g = __uint_as_float(((unsigned)gv[i]) << 16);
                    const float ov = (hfv[i] + hv[i]) * gelu_tanh(g);
                    mix[(size_t)(tb + t0 + tl) * D + 1024 + c0 + c] = (bf16_t)(cvt_pk_bf16(ov, 0.f) & 0xffffu); }
            }
        }
        __syncthreads();
        if (seq < 32 && tid < 128) p.out[OUT_LRU + (size_t)seq * 2048 + dir * 1024 + c0 + tid] = HC[tid];
    }
    __syncthreads();
}

constexpr int PS_ROW = 129;
#define PS_WAVE_SYNC() do { __builtin_amdgcn_fence(__ATOMIC_ACQ_REL, "wavefront"); __builtin_amdgcn_wave_barrier(); } while (0)
#define PS_INSERT(tv, v) do { _Pragma("unroll") for (int _i = 15; _i >= 1; --_i) tv[_i] = __builtin_amdgcn_fmed3f(tv[_i - 1], tv[_i], (v)); tv[0] = fmaxf(tv[0], (v)); } while (0)
DI void peer_select_phase(const Params& p, int l, LAS unsigned char* lds) {
    const int tid = threadIdx.x, lane = tid & 63, wave = __builtin_amdgcn_readfirstlane(tid >> 6), fr = lane & 15, fq = lane >> 4;
    const bf16_t* qp = (const bf16_t*)(p.ws + WS_MIX);
    const bf16_t* skl = (const bf16_t*)(p.ws + WS_SK) + (size_t)l * 8 * 2 * 128 * 128;
    int* pidx = (int*)(p.ws + WS_PIDX); float* pgate = (float*)(p.ws + WS_PGATE);
    LAS float* SCw = (LAS float*)lds + wave * (32 * PS_ROW);
    for (int u = blockIdx.x; u < 1280; u += gridDim.x) {
        const int head = u / 160, tile = u % 160, tw = tile * 256 + 32 * wave;
        float alist[16], blist[16];
#pragma unroll
        for (int pp = 0; pp < 2; ++pp) {
            f32x4 acc[2][8];
#pragma unroll
            for (int g = 0; g < 2; ++g)
#pragma unroll
                for (int kb = 0; kb < 8; ++kb) acc[g][kb] = (f32x4){0.f, 0.f, 0.f, 0.f};
            const bf16_t* qrow = qp + (size_t)(tw + fr) * D + head * 256 + pp * 128 + 8 * fq;
            const bf16_t* kbase = skl + ((size_t)(head * 2 + pp) * 128 + fr) * 128 + 8 * fq;
#pragma unroll
            for (int ks = 0; ks < 4; ++ks) { const bf16x8 af0 = *(const bf16x8*)(qrow + 32 * ks), af1 = *(const bf16x8*)(qrow + (size_t)16 * D + 32 * ks);
#pragma unroll
                for (int kb = 0; kb < 8; ++kb) { const bf16x8 bf = *(const bf16x8*)(kbase + (size_t)(16 * kb) * 128 + 32 * ks); acc[0][kb] = MFMA16(af0, bf, acc[0][kb]); acc[1][kb] = MFMA16(af1, bf, acc[1][kb]); } }
#pragma unroll
            for (int g = 0; g < 2; ++g)
#pragma unroll
                for (int kb = 0; kb < 8; ++kb)
#pragma unroll
                    for (int rg = 0; rg < 4; ++rg) SCw[(16 * g + 4 * fq + rg) * PS_ROW + 16 * kb + fr] = acc[g][kb][rg];
            PS_WAVE_SYNC();
            { LAS float* sp = SCw + (lane >> 1) * PS_ROW + 64 * (lane & 1);
              float tv[16];
#pragma unroll
              for (int i = 0; i < 16; ++i) tv[i] = -INFINITY;
#pragma unroll 4
              for (int k = 0; k < 64; ++k) { const float v = __uint_as_float((__float_as_uint(sp[k]) & ~127u) | (unsigned)(64 * (lane & 1) + k)); PS_INSERT(tv, v); }
#pragma unroll
              for (int i = 0; i < 16; ++i) sp[i] = tv[i]; }
            PS_WAVE_SYNC();
            if (lane < 32) { const LAS float* sp = SCw + lane * PS_ROW; float tv[16], ob[16];
#pragma unroll
                for (int i = 0; i < 16; ++i) { tv[i] = sp[i]; ob[i] = sp[64 + i]; }
#pragma unroll
                for (int i = 0; i < 16; ++i) PS_INSERT(tv, ob[i]);
#pragma unroll
                for (int i = 0; i < 16; ++i) { if (pp == 0) alist[i] = tv[i]; else blist[i] = tv[i]; } }
            PS_WAVE_SYNC();
        }
        if (lane < 32) {
            LAS float* pa = SCw + lane * PS_ROW; LAS float* pb = pa + 64;
#pragma unroll
            for (int i = 0; i < 16; ++i) { pa[i] = alist[i]; pb[i] = blist[i]; }
            float tv[16];
#pragma unroll
            for (int i = 0; i < 16; ++i) tv[i] = -INFINITY;
#pragma unroll
            for (int i = 0; i < 16; ++i)
#pragma unroll
                for (int j = 0; j < 16; ++j) if ((i + 1) * (j + 1) <= 16) { const float cvv = __uint_as_float((__float_as_uint(alist[i] + blist[j]) & ~255u) | (unsigned)(i * 16 + j)); PS_INSERT(tv, cvv); }
            float bs[16]; int bidx[16];
#pragma unroll
            for (int k = 0; k < 16; ++k) { const unsigned code = __float_as_uint(tv[k]) & 255u; const int i1 = (int)(__float_as_uint(pa[code >> 4]) & 127u), i2 = (int)(__float_as_uint(pb[code & 15u]) & 127u);
                bidx[k] = i1 * 128 + i2; bs[k] = tv[k]; }
            float den = 0.f; const float bmax = bs[0];
#pragma unroll
            for (int k = 0; k < 16; ++k) { bs[k] = __expf(bs[k] - bmax); den += bs[k]; }
            const float inv = 1.f / den;
            const size_t ob = (size_t)(tw + lane) * 128 + head * 16;
#pragma unroll
            for (int k4 = 0; k4 < 4; ++k4) { *(int4*)(pidx + ob + 4 * k4) = make_int4(bidx[4 * k4], bidx[4 * k4 + 1], bidx[4 * k4 + 2], bidx[4 * k4 + 3]);
                *(f32x4*)(pgate + ob + 4 * k4) = (f32x4){bs[4 * k4] * inv, bs[4 * k4 + 1] * inv, bs[4 * k4 + 2] * inv, bs[4 * k4 + 3] * inv}; }
        }
        PS_WAVE_SYNC();
    }
}

#define PG_ISSUE(UB, VB, e) do { const int _id = __builtin_amdgcn_readlane(((e) < 64) ? idA : idB, (e) & 63); unsigned _lo = loff; asm("" : "+v"(_lo));   \
    const unsigned char* _u = U6 + (size_t)_id * PROW; const unsigned char* _v = V6 + (size_t)_id * PROW; \
    UB[0] = *(const u32x2*)(_u + _lo); UB[1] = *(const u32x2*)(_u + _lo + 8); UB[2] = *(const u32x2*)(_u + _lo + 16); VB[0] = *(const u32x2*)(_v + _lo); VB[1] = *(const u32x2*)(_v + _lo + 8); VB[2] = *(const u32x2*)(_v + _lo + 16); } while (0)
#define PG_LANEF(A, B, e) __int_as_float(__builtin_amdgcn_readlane(__float_as_int(((e) < 64) ? A : B), (e) & 63))
#define PG_DEC(B) __builtin_amdgcn_cvt_scalef32_pk32_f32_fp6((u32x6){B[0].x, B[0].y, B[1].x, B[1].y, B[2].x, B[2].y}, 1.0f)
#define PG_COMPUTE(UB, VB, e) do { float _d0 = 0.f, _d1 = 0.f; { const f32x32 _ud = PG_DEC(UB); \
    _Pragma("unroll") for (int _i = 0; _i < 32; _i += 2) { _d0 += xf[_i] * _ud[_i]; _d1 += xf[_i + 1] * _ud[_i + 1]; } } \
    const float _d = wave_sum_dpp(_d0 + _d1) * PG_LANEF(suA, suB, e); const float _a = gelu_tanh(_d) * PG_LANEF(gsA, gsB, e); \
    { const f32x32 _vd = PG_DEC(VB); _Pragma("unroll") for (int _i = 0; _i < 32; ++_i) o[_i] += _a * _vd[_i]; } } while (0)
DI void wave_sum_dpp2(float a, float b, float& ra, float& rb) {
    a += dpp_get<0xB1, 0xf>(a); b += dpp_get<0xB1, 0xf>(b); a += dpp_get<0x4E, 0xf>(a); b += dpp_get<0x4E, 0xf>(b);
    a += dpp_get<0x141, 0xf>(a); b += dpp_get<0x141, 0xf>(b); a += dpp_get<0x140, 0xf>(a); b += dpp_get<0x140, 0xf>(b);
    a += dpp_get<0x142, 0xa>(a); b += dpp_get<0x142, 0xa>(b); a += dpp_get<0x143, 0xc>(a); b += dpp_get<0x143, 0xc>(b);
    ra = __int_as_float(__builtin_amdgcn_readlane(__float_as_int(a), 63)); rb = __int_as_float(__builtin_amdgcn_readlane(__float_as_int(b), 63));
}
#define PG_DECH(B) __builtin_bit_cast(H16, __builtin_amdgcn_cvt_scalef32_pk32_f16_fp6((u32x6){B[0].x, B[0].y, B[1].x, B[1].y, B[2].x, B[2].y}, 1.0f))
#define PG_COMPUTE2(UA, VA, UB, VB, e) do { float _a0 = 0.f, _a1 = 0.f, _b0 = 0.f, _b1 = 0.f; { const f32x32 _ua = PG_DEC(UA); const f32x32 _ub = PG_DEC(UB); \
    _Pragma("unroll") for (int _i = 0; _i < 32; _i += 2) { _a0 += xf[_i] * _ua[_i]; _b0 += xf[_i] * _ub[_i]; _a1 += xf[_i + 1] * _ua[_i + 1]; _b1 += xf[_i + 1] * _ub[_i + 1]; } } \
    float _da, _db; wave_sum_dpp2(_a0 + _a1, _b0 + _b1, _da, _db); _da *= PG_LANEF(suA, suB, e); _db *= PG_LANEF(suA, suB, (e) + 1); \
    const float _ga = gelu_tanh(_da) * PG_LANEF(gsA, gsB, e), _gb = gelu_tanh(_db) * PG_LANEF(gsA, gsB, (e) + 1); \
    { const H16 _vd = PG_DECH(VA); const _Float16 _h = (_Float16)(_ga * 256.f); const h2 _g2 = {_h, _h}; _Pragma("unroll") for (int _i = 0; _i < 16; ++_i) o2[_i] = _g2 * _vd.v[_i] + o2[_i]; } \
    { const H16 _vd = PG_DECH(VB); const _Float16 _h = (_Float16)(_gb * 256.f); const h2 _g2 = {_h, _h}; _Pragma("unroll") for (int _i = 0; _i < 16; ++_i) o2[_i] = _g2 * _vd.v[_i] + o2[_i]; } } while (0)
DI void peer_gather_phase(const Params& p, int l, bool last, LAS unsigned char* lds) {
    const int tid = threadIdx.x, lane = tid & 63, wave = __builtin_amdgcn_readfirstlane(tid >> 6); const unsigned loff = 24u * (unsigned)lane;
    const unsigned char* U6 = p.ws + WS_PU + (size_t)l * PEER_N * PROW;
    const unsigned char* V6 = p.ws + WS_PV + (size_t)l * PEER_N * PROW;
    const float* su = (const float*)(p.ws + WS_PSU) + l * PEER_N; const float* sv = (const float*)(p.ws + WS_PSV) + l * PEER_N;
    const int* pidx = (const int*)(p.ws + WS_PIDX); const float* pgate = (const float*)(p.ws + WS_PGATE);
    bf16_t* hbuf = (bf16_t*)(p.ws + WS_H);
    float* xres = p.out + OUT_YP;
    const float* mod = (const float*)(p.ws + WS_MOD);
    for (int tok = blockIdx.x * NWAVES + wave; tok < NTOK; tok += gridDim.x * NWAVES) {
        int ln = lane; asm volatile("" : "+v"(ln));
        float xf[32];
#pragma unroll
        for (int q = 0; q < 4; ++q) { const u32x4 a = *(const u32x4*)(hbuf + (size_t)tok * D + 32 * ln + 8 * q);
            xf[8 * q] = bf_lo(a.x); xf[8 * q + 1] = bf_hi(a.x); xf[8 * q + 2] = bf_lo(a.y); xf[8 * q + 3] = bf_hi(a.y); xf[8 * q + 4] = bf_lo(a.z); xf[8 * q + 5] = bf_hi(a.z); xf[8 * q + 6] = bf_lo(a.w); xf[8 * q + 7] = bf_hi(a.w); }
        int idA = pidx[(size_t)tok * 128 + ln], idB = pidx[(size_t)tok * 128 + 64 + ln];
        float gA = pgate[(size_t)tok * 128 + ln], gB = pgate[(size_t)tok * 128 + 64 + ln];
        { int rA = 0, rB = 0;
          for (int j = 0; j < 64; ++j) { const int ja = __builtin_amdgcn_readlane(idA, j), jb = __builtin_amdgcn_readlane(idB, j);
              rA += (ja < idA || (ja == idA && j < lane)) ? 1 : 0; rA += (jb < idA) ? 1 : 0;
              rB += (ja <= idB) ? 1 : 0; rB += (jb < idB || (jb == idB && j < lane)) ? 1 : 0; }
          LAS int* sid = (LAS int*)(lds + wave * 1024); LAS float* sg = (LAS float*)(lds + wave * 1024 + 512);
          sid[rA] = idA; sg[rA] = gA; sid[rB] = idB; sg[rB] = gB;
          idA = sid[lane]; gA = sg[lane]; idB = sid[64 + lane]; gB = sg[64 + lane]; }
        const float suA = su[idA], suB = su[idB], gsA = gA * sv[idA], gsB = gB * sv[idB];
        h2 o2[16];
#pragma unroll
        for (int j = 0; j < 16; ++j) o2[j] = (h2){(_Float16)0.f, (_Float16)0.f};
        u32x2 u0[3], v0[3], u1[3], v1[3], u2[3], v2[3], u3[3], v3[3];
        PG_ISSUE(u0, v0, 0); PG_ISSUE(u1, v1, 1);
        for (int e = 0; e < 124; e += 4) {
            PG_ISSUE(u2, v2, e + 2); PG_ISSUE(u3, v3, e + 3);
            PG_COMPUTE2(u0, v0, u1, v1, e);
            PG_ISSUE(u0, v0, e + 4); PG_ISSUE(u1, v1, e + 5);
            PG_COMPUTE2(u2, v2, u3, v3, e + 2);
        }
        PG_ISSUE(u2, v2, 126); PG_ISSUE(u3, v3, 127);
        PG_COMPUTE2(u0, v0, u1, v1, 124);
        PG_COMPUTE2(u2, v2, u3, v3, 126);
        float o[32];
#pragma unroll
        for (int j = 0; j < 16; ++j) { o[2 * j] = (float)o2[j].x * (1.f / 256.f); o[2 * j + 1] = (float)o2[j].y * (1.f / 256.f); }
        const float* mc = mod + (size_t)(l * 9 + cond_of_row(tok)) * 12288;
        f32x4 xn[8]; float ss = 0.f;
#pragma unroll
        for (int q = 0; q < 8; ++q) { const int eo = 32 * ln + 4 * q; const f32x4 xv = *(const f32x4*)(xres + (size_t)tok * D + eo), gt = *(const f32x4*)(mc + 5 * D + eo);
#pragma unroll
            for (int j = 0; j < 4; ++j) { xn[q][j] = xv[j] + gt[j] * o[4 * q + j]; ss += xn[q][j] * xn[q][j]; } }
        ss = wave_sum(ss);
        const float rs = rsqrtf(ss * (1.f / 2048.f) + 1e-6f);
        if (!last) {
            const float* mn = mod + (size_t)((l + 1) * 9 + cond_of_row(tok)) * 12288; const float* g = p.norm1_g + (l + 1) * D;
            u32x4 w[4];
#pragma unroll
            for (int q2 = 0; q2 < 4; ++q2)
#pragma unroll
                for (int hq = 0; hq < 2; ++hq) { const int q = 2 * q2 + hq, eo = 32 * ln + 4 * q;
                    const f32x4 gv = *(const f32x4*)(g + eo), sh = *(const f32x4*)(mn + eo), sc = *(const f32x4*)(mn + D + eo); float y[4];
#pragma unroll
                    for (int j = 0; j < 4; ++j) y[j] = xn[q][j] * rs * gv[j] * (1.f + sc[j]) + sh[j];
                    w[q2][2 * hq] = cvt_pk_bf16(y[0], y[1]); w[q2][2 * hq + 1] = cvt_pk_bf16(y[2], y[3]); }
            asm volatile("" ::: "memory");
#pragma unroll
            for (int q = 0; q < 8; ++q) *(f32x4*)(xres + (size_t)tok * D + 32 * ln + 4 * q) = xn[q];
#pragma unroll
            for (int q2 = 0; q2 < 4; ++q2) *(u32x4*)(hbuf + (size_t)tok * D + 32 * ln + 8 * q2) = w[q2];
        } else {
            f32x4 y[8];
#pragma unroll
            for (int q = 0; q < 8; ++q) { const int eo = 32 * ln + 4 * q; const f32x4 gv = *(const f32x4*)(p.final_norm_g + eo);
#pragma unroll
                for (int j = 0; j < 4; ++j) y[q][j] = xn[q][j] * rs * gv[j]; }
            asm volatile("" ::: "memory");
#pragma unroll
            for (int q = 0; q < 8; ++q) *(f32x4*)(xres + (size_t)tok * D + 32 * ln + 4 * q) = y[q];
        }
    }
}

constexpr int N_PHASES = 16;
#ifndef MK_SPLIT
#define MK_SPLIT 0
#endif

__global__ void __launch_bounds__(NTHR, 2) mk_fwd(Params p) {
    extern __shared__ __attribute__((aligned(16))) unsigned char lds_raw[];
    LAS unsigned char* lds = (LAS unsigned char*)lds_raw;
    const int tid = threadIdx.x;
    volatile LAS unsigned* misc = (volatile LAS unsigned*)(lds + LDS_MISC);
    if (tid < 64) misc[tid] = 0u;
    __syncthreads();
    unsigned char* ws = p.ws;
    XcdBarrier bar; bar.bar = (unsigned*)(ws + WS_BAR); bar.x = 0; bar.st = nullptr;
    const bool fused = (p.ph_hi - p.ph_lo) > 1;
    if (fused) bar = xcd_barrier_post((unsigned*)(ws + WS_BAR), misc + 8);
#define PH(k) (p.ph_lo <= (k) && (k) < p.ph_hi)
#define SEAM(k) do { if (p.ph_lo <= (k) && (k) + 1 < p.ph_hi) xcd_barrier(bar); } while (0)
    float* mod = (float*)(ws + WS_MOD);
    bf16_t* hbuf = (bf16_t*)(ws + WS_H);
    bf16_t* proj = (bf16_t*)(ws + WS_PROJ);
    bf16_t* mix = (bf16_t*)(ws + WS_MIX);
    float* xres = p.out + OUT_YP;

    if (PH(0)) prologue_phase(p, lds);
    SEAM(0);
    if (PH(1)) norm_phase<true>(p, 0, 0);
    SEAM(1);
    if (PH(2)) {
        pg8::Gemm g; g.A = hbuf; g.Bt = (const bf16_t*)(ws + WS_WEI); g.M = NTOK; g.N = EVEN_IN; g.K = D;
        pg8::StaticOrder S; S.init(g.M, g.N, (int)gridDim.x, (int)blockIdx.x);
        EpiProj E; E.O = proj; E.ldc = EVEN_IN; E.outK = p.out + OUT_AK; E.outV = p.out + OUT_AV; E.kstart = 1024; E.vstart = 2048; E.kvw = 1024; E.rope = (const float*)(ws + WS_ROPE);
        pg8::gemm_phase<EpiProj, pg8::StaticOrder, false>(lds, g, S, E, nullptr);
    }
    SEAM(2);
    if (PH(3)) {
        unsigned* ctrL = (unsigned*)(ws + WS_CTR); unsigned* ctrA = ctrL + 64;
        for (;;) {
            const int u = q_next(ctrL, misc);
            if (u >= 320) break;
            const int seq = u < 64 ? 32 + (u >> 3) : ((u - 64) >> 3), blk = u & 7;
            lru_unit(p, lds, seq, blk);
        }
        const bf16_t* cak = (const bf16_t*)(ws + WS_CAK); const bf16_t* cav = (const bf16_t*)(ws + WS_CAV);
        const float lam = ((const float*)(ws + WS_SCAL))[0];
        for (;;) {
            const int u = q_next(ctrA, misc);
            if (u >= 2560) break;
            AttnArgs a; a.C = 0.125f * 1.4426950408889634f; a.lam = lam; a.subg = p.a_subln_g; a.rpb = nullptr; a.qr0 = 0; a.krlo = 0; a.ldq = EVEN_IN; a.ldo = D; a.ld1 = EVEN_IN;
            if (u < 2048) { const int b = u >> 8, head = (u & 255) >> 5, qb = u & 31; const size_t tb = NP + (size_t)b * TS;
                a.Q = proj + (tb + 128 * qb) * EVEN_IN + head * 128;
                a.K0 = cak + (size_t)b * PAST * 1024 + head * 128; a.V0 = cav + (size_t)b * PAST * 1024 + head * 128; a.n0 = PAST; a.ld0 = 1024;
                a.K1 = proj + tb * EVEN_IN + 1024 + head * 128; a.V1 = proj + tb * EVEN_IN + 2048 + head * 128; a.n1 = TS;
                a.O = mix + (tb + 128 * qb) * D + head * 128;
            } else { const int i = u - 2048, b = i >> 4, head = (i & 15) >> 1, half = i & 1; const size_t tb = (size_t)b * TP;
                a.Q = proj + (tb + 128 * half) * EVEN_IN + head * 128;
                a.K0 = proj + tb * EVEN_IN + 1024 + head * 128; a.V0 = proj + tb * EVEN_IN + 2048 + head * 128; a.n0 = TP; a.ld0 = EVEN_IN;
                a.K1 = a.K0; a.V1 = a.V0; a.n1 = 0;
                a.O = mix + (tb + 128 * half) * D + head * 128;
            }
            attn_unit<0>(lds, a);
        }
    }
    SEAM(3);
    if (PH(4)) {
        pg8::Gemm g; g.A = mix; g.Bt = (const bf16_t*)(ws + WS_WEO); g.M = NTOK; g.N = D; g.K = D;
        pg8::StaticOrder S; S.init(g.M, g.N, (int)gridDim.x, (int)blockIdx.x);
        EpiResid E; E.xin_p = p.x_prompt; E.xin_s = p.x_sample; E.xout = xres; E.gate = mod + 2 * D;
        pg8::gemm_phase<EpiResid, pg8::StaticOrder, false>(lds, g, S, E, nullptr);
    }
    SEAM(4);
    if (PH(5)) norm_phase<false>(p, 0, 1);
    SEAM(5);
    if (PH(6)) {
        pg8::Gemm g; g.A = hbuf; g.Bt = (const bf16_t*)(ws + WS_WPQ); g.M = NTOK; g.N = D; g.K = D;
        pg8::StaticOrder S; S.init(g.M, g.N, (int)gridDim.x, (int)blockIdx.x);
        EpiBf E; E.O = mix; E.ldc = D;
        pg8::gemm_phase<EpiBf, pg8::StaticOrder, false>(lds, g, S, E, nullptr);
    }
    SEAM(6);
    if (PH(7)) peer_select_phase(p, 0, lds);
    SEAM(7);
    if (PH(8)) peer_gather_phase(p, 0, false, lds);
    SEAM(8);
    if (PH(9)) {
        pg8::Gemm g; g.A = hbuf; g.Bt = (const bf16_t*)(ws + WS_WOI); g.M = NTOK; g.N = ODD_IN; g.K = D;
        pg8::StaticOrder S; S.init(g.M, g.N, (int)gridDim.x, (int)blockIdx.x);
        EpiProj E; E.O = proj; E.ldc = ODD_IN; E.outK = p.out + OUT_CK; E.outV = p.out + OUT_CV; E.kstart = 2048; E.vstart = 4096; E.kvw = 2048; E.rope = nullptr;
        pg8::gemm_phase<EpiProj, pg8::StaticOrder, false>(lds, g, S, E, nullptr);
    }
    SEAM(9);
    if (PH(10)) {
        unsigned* ctrN = (unsigned*)(ws + WS_CTR) + 128; unsigned* ctrD = ctrN + 64;
        const bf16_t* cck = (const bf16_t*)(ws + WS_CCK); const bf16_t* ccv = (const bf16_t*)(ws + WS_CCV);
        for (;;) {
            const int u = q_next(ctrN, misc);
            if (u >= 2048) break;
            AttnArgs a; a.C = 0.08838834764831845f * 1.4426950408889634f; a.lam = 0.f; a.subg = nullptr; a.ldq = ODD_IN; a.ldo = D;
            const int b = u >> 8, head = (u & 255) >> 4, rb = u & 15; const size_t tb = NP + (size_t)b * TS;
            const int krlo = min(max(4 * rb - 4, 0), 56), krhi = min(max(4 * rb - 1, 0), 56) + 7;
            a.Q = proj + (tb + 256 * rb) * ODD_IN + head * 128;
            a.K0 = cck + (size_t)b * PAST * 2048 + head * 128; a.V0 = ccv + (size_t)b * PAST * 2048 + head * 128; a.n0 = PAST; a.ld0 = 2048;
            a.K1 = proj + (tb + 64 * krlo) * ODD_IN + 2048 + head * 128; a.V1 = proj + (tb + 64 * krlo) * ODD_IN + 4096 + head * 128; a.n1 = (krhi - krlo + 1) * 64; a.ld1 = ODD_IN;
            a.O = mix + (tb + 256 * rb) * D + head * 128; a.rpb = p.na_rpb + head * 465; a.qr0 = 4 * rb; a.krlo = krlo;
            attn_unit<2>(lds, a);
        }
        for (;;) {
            const int u = q_next(ctrD, misc);
            if (u >= 512) break;
            AttnArgs a; a.C = 0.08838834764831845f * 1.4426950408889634f; a.lam = 0.f; a.subg = nullptr; a.ldq = ODD_IN; a.ldo = D;
            const int b = u >> 4, head = u & 15; const size_t tb = (size_t)b * TP;
            a.Q = proj + tb * ODD_IN + head * 128;
            a.K0 = proj + tb * ODD_IN + 2048 + head * 128; a.V0 = proj + tb * ODD_IN + 4096 + head * 128; a.n0 = TP; a.ld0 = ODD_IN;
            a.K1 = a.K0; a.V1 = a.V0; a.n1 = 0; a.ld1 = ODD_IN;
            a.O = mix + tb * D + head * 128; a.rpb = nullptr; a.qr0 = 0; a.krlo = 0;
            attn_unit<1>(lds, a);
        }
    }
    SEAM(10);
    if (PH(11)) {
        pg8::Gemm g; g.A = mix; g.Bt = (const bf16_t*)(ws + WS_WOO); g.M = NTOK; g.N = D; g.K = D;
        pg8::StaticOrder S; S.init(g.M, g.N, (int)gridDim.x, (int)blockIdx.x);
        EpiResid E; E.xin_p = xres; E.xin_s = xres + (size_t)NP * D; E.xout = xres; E.gate = mod + (size_t)9 * 12288 + 2 * D;
        pg8::gemm_phase<EpiResid, pg8::StaticOrder, false>(lds, g, S, E, nullptr);
    }
    SEAM(11);
    if (PH(12)) norm_phase<false>(p, 1, 1);
    SEAM(12);
    if (PH(13)) {
        pg8::Gemm g; g.A = hbuf; g.Bt = (const bf16_t*)(ws + WS_WPQ) + (size_t)D * D; g.M = NTOK; g.N = D; g.K = D;
        pg8::StaticOrder S; S.init(g.M, g.N, (int)gridDim.x, (int)blockIdx.x);
        EpiBf E; E.O = mix; E.ldc = D;
        pg8::gemm_phase<EpiBf, pg8::StaticOrder, false>(lds, g, S, E, nullptr);
    }
    SEAM(13);
    if (PH(14)) peer_select_phase(p, 1, lds);
    SEAM(14);
    if (PH(15)) peer_gather_phase(p, 1, true, lds);

#undef PH
#undef SEAM
}

extern "C" void kernel_launch(void* const* d_in, const int* in_sizes, int n_in, void* d_out, int out_size, void* d_ws, size_t ws_size, hipStream_t stream) {
    static int grid = 0;
    if (grid == 0) {
        if (n_in != 32 || ws_size < WS_END || (size_t)out_size != OUT_END) { fprintf(stderr, "kernel_launch: unexpected shapes: n_in %d out %d ws %zu (need %zu)\n", n_in, out_size, ws_size, (size_t)WS_END); grid = -1; return; }
        int dev = 0, cus = 0, per_cu = 0;
        if (hipGetDevice(&dev) != hipSuccess || hipDeviceGetAttribute(&cus, hipDeviceAttributeMultiprocessorCount, dev) != hipSuccess) { grid = -1; return; }
        if (hipFuncSetAttribute((const void*)mk_fwd, hipFuncAttributeMaxDynamicSharedMemorySize, LDS_BYTES) != hipSuccess) { fprintf(stderr, "kernel_launch: hipFuncSetAttribute failed\n"); grid = -1; return; }
        if (hipOccupancyMaxActiveBlocksPerMultiprocessor(&per_cu, (const void*)mk_fwd, NTHR, LDS_BYTES) != hipSuccess || per_cu < 1) { fprintf(stderr, "kernel_launch: occupancy query says %d\n", per_cu); }
        (void)hipGetLastError();
        grid = cus;
    }
    if (grid < 0) return;
    (void)hipMemsetAsync((char*)d_ws + WS_BAR, 0, WS_ZERO_BYTES, stream);
    Params p{};
    const float** pp = (const float**)&p;
    for (int i = 0; i < 32; ++i) pp[i] = (const float*)d_in[i];
    p.out = (float*)d_out; p.ws = (unsigned char*)d_ws;
#if MK_SPLIT
    for (int k = 0; k < N_PHASES; ++k) { p.ph_lo = k; p.ph_hi = k + 1; hipLaunchKernelGGL(mk_fwd, dim3(grid), dim3(NTHR), LDS_BYTES, stream, p); }
#else
    p.ph_lo = 0; p.ph_hi = N_PHASES;
    hipLaunchKernelGGL(mk_fwd, dim3(grid), dim3(NTHR), LDS_BYTES, stream, p);
#endif
    const hipError_t le = hipPeekAtLastError();
    if (le != hipSuccess) fprintf(stderr, "kernel_launch: launch failed: %s\n", hipGetErrorName(le));
}
```

```cpp
#include <hip/hip_runtime.h>
#include <stdint.h>
#include <stdio.h>

#define LAS __attribute__((address_space(3)))
typedef unsigned short bf16_t;
typedef short bf16x8 __attribute__((ext_vector_type(8)));
typedef short s16x4 __attribute__((ext_vector_type(4)));
typedef float f32x2 __attribute__((ext_vector_type(2)));
typedef float f32x4 __attribute__((ext_vector_type(4)));
typedef float f32x16 __attribute__((ext_vector_type(16)));
typedef unsigned u32x2 __attribute__((ext_vector_type(2)));
typedef unsigned u32x4 __attribute__((ext_vector_type(4)));
typedef unsigned u32x6 __attribute__((ext_vector_type(6)));
typedef unsigned u32x16 __attribute__((ext_vector_type(16)));
typedef float f32x32 __attribute__((ext_vector_type(32)));
typedef _Float16 h2 __attribute__((ext_vector_type(2)));
struct H16 { h2 v[16]; };
#define DI __device__ __forceinline__

constexpr int D = 2048, NP = 8192  , NS = 32768  , NTOK = NP + NS;
constexpr int TP = 256, TS = 4096, PAST = 512;
constexpr int EVEN_IN = 5120, ODD_IN = 6144;
constexpr int PEER_N = 16384;
constexpr int NWAVES = 8, NTHR = 512;
constexpr int LDS_BYTES = 147456;
constexpr int LDS_MISC = LDS_BYTES - 256;

constexpr size_t OUT_YP = 0, OUT_YS = OUT_YP + (size_t)NP * D, OUT_AK = OUT_YS + (size_t)NS * D, OUT_AV = OUT_AK + (size_t)NP * 1024,
                 OUT_LRU = OUT_AV + (size_t)NP * 1024, OUT_CK = OUT_LRU + 32 * 2 * 1024, OUT_CV = OUT_CK + (size_t)NP * 2048, OUT_END = OUT_CV + (size_t)NP * 2048;

constexpr size_t al256(size_t x) { return (x + 255) & ~(size_t)255; }
constexpr size_t WS_BAR = 0;
constexpr size_t WS_CTR = 16384;
constexpr size_t WS_ZERO_BYTES = 20480;
constexpr size_t WS_SCAL = WS_ZERO_BYTES;
constexpr size_t WS_ROPE = WS_SCAL + 256;
constexpr size_t WS_MOD = al256(WS_ROPE + 64 * 16 * 2 * 4);
constexpr size_t WS_WEI = al256(WS_MOD + (size_t)2 * 9 * 12288 * 4);
constexpr size_t WS_WEO = WS_WEI + (size_t)EVEN_IN * D * 2;
constexpr size_t WS_WOI = WS_WEO + (size_t)D * D * 2;
constexpr size_t WS_WOO = WS_WOI + (size_t)ODD_IN * D * 2;
constexpr size_t WS_WPQ = WS_WOO + (size_t)D * D * 2;
constexpr size_t WS_SK = WS_WPQ + (size_t)2 * D * D * 2;
constexpr size_t WS_LRW = WS_SK + (size_t)2 * 8 * 2 * 128 * 128 * 2;
constexpr size_t WS_CAK = WS_LRW + (size_t)2 * 2 * 8 * 128 * 128 * 2;
constexpr size_t WS_CAV = WS_CAK + (size_t)8 * 512 * 1024 * 2;
constexpr size_t WS_CCK = WS_CAV + (size_t)8 * 512 * 1024 * 2;
constexpr size_t WS_CCV = WS_CCK + (size_t)8 * 512 * 2048 * 2;
constexpr int PROW = 1536;
constexpr size_t WS_PU = WS_CCV + (size_t)8 * 512 * 2048 * 2;
constexpr size_t WS_PV = WS_PU + (size_t)2 * PEER_N * PROW;
constexpr size_t WS_PSU = WS_PV + (size_t)2 * PEER_N * PROW;
constexpr size_t WS_PSV = WS_PSU + (size_t)2 * PEER_N * 4;
constexpr size_t WS_H = WS_PSV + (size_t)2 * PEER_N * 4;
constexpr size_t WS_PROJ = WS_H + (size_t)NTOK * D * 2;
constexpr size_t WS_MIX = WS_PROJ + (size_t)NTOK * ODD_IN * 2;
constexpr size_t WS_PIDX = WS_MIX + (size_t)NTOK * D * 2;
constexpr size_t WS_PGATE = WS_PIDX + (size_t)NTOK * 128 * 4;
constexpr size_t WS_END = WS_PGATE + (size_t)NTOK * 128 * 4;

struct Params {
    const float *x_prompt, *x_sample, *cache_a_k, *cache_a_v, *state_lru, *cache_c_k, *cache_c_v, *c, *c_ctx, *w_mod, *b_mod, *norm1_g, *norm2_g, *final_norm_g,
        *even_w_in, *even_w_out, *a_lambda, *a_subln_g, *lru_conv_w, *lru_conv_b, *lru_w_a, *lru_b_a, *lru_w_i, *lru_b_i, *lru_lambda,
        *odd_w_in, *odd_w_out, *na_rpb, *peer_w_q, *peer_sub_keys, *peer_u, *peer_v;
    float* out; unsigned char* ws; int ph_lo, ph_hi;
};

DI unsigned cvt_pk_bf16(float lo, float hi) { unsigned r; asm volatile("v_cvt_pk_bf16_f32 %0, %1, %2" : "=v"(r) : "v"(lo), "v"(hi)); return r; }
DI float bf_lo(unsigned u) { return __uint_as_float(u << 16); }
DI float bf_hi(unsigned u) { return __uint_as_float(u & 0xffff0000u); }
DI float wave_sum(float v) { v += __shfl_xor(v, 1); v += __shfl_xor(v, 2); v += __shfl_xor(v, 4); v += __shfl_xor(v, 8); v += __shfl_xor(v, 16); v += __shfl_xor(v, 32); return v; }
template <int CTRL, int ROWMASK> DI float dpp_get(float v) { return __int_as_float(__builtin_amdgcn_update_dpp(0, __float_as_int(v), CTRL, ROWMASK, 0xf, false)); }
DI float wave_sum_dpp(float v) {
    v += dpp_get<0xB1, 0xf>(v); v += dpp_get<0x4E, 0xf>(v); v += dpp_get<0x141, 0xf>(v); v += dpp_get<0x140, 0xf>(v);
    v += dpp_get<0x142, 0xa>(v); v += dpp_get<0x143, 0xc>(v);
    return __int_as_float(__builtin_amdgcn_readlane(__float_as_int(v), 63));
}
DI int cond_of_row(int row) { return row < NP ? 0 : 1 + ((row - NP) >> 12); }
DI float gelu_tanh(float x) { const float u2 = (2.f * 0.7978845608028654f * 1.4426950408889634f) * (x + 0.044715f * x * x * x); return x * __builtin_amdgcn_rcpf(1.f + __builtin_amdgcn_exp2f(-u2)); }

#define XB_TMO      128
#define XB_XCNT(j)  (256  + 64 * (j))
#define XB_XSUB(j)  (1280 + 64 * (j))
#define XB_XGEN(j)  (2304 + 64 * (j))
#define XB_TOP      3328
#define XB_TOPGEN   3392
#define XCD_BAR_WORDS 3456
#define XB_SPIN_CAP (1u << 18)

__device__ __forceinline__ unsigned xb_ld(unsigned* p)              { return __hip_atomic_load(p, __ATOMIC_RELAXED, __HIP_MEMORY_SCOPE_AGENT); }
__device__ __forceinline__ unsigned xb_add(unsigned* p, unsigned v) { return __hip_atomic_fetch_add(p, v, __ATOMIC_RELAXED, __HIP_MEMORY_SCOPE_AGENT); }
__device__ __forceinline__ unsigned xb_xcc_id() { return (unsigned)__builtin_amdgcn_s_getreg((3 << 11) | 20) & 0xFu; }
#define XB_SPIN(cond, bar) do { unsigned _sp = 0; while (cond) { __builtin_amdgcn_s_sleep(1); \
    if ((++_sp & 255u) == 0u) { if (xb_ld(&(bar)[XB_TMO])) break; if (_sp > XB_SPIN_CAP) { atomicAdd(&(bar)[XB_TMO], 1u); break; } } } } while (0)

struct XcdBarrier {
    unsigned* bar; unsigned x;
    volatile LAS unsigned* st;
};

__device__ __forceinline__ XcdBarrier xcd_barrier_post(unsigned* bar, volatile LAS unsigned* st) {
    XcdBarrier b; b.bar = bar; b.x = xb_xcc_id(); b.st = st;
    if (threadIdx.x == 0) (void)xb_add(&bar[XB_XCNT(b.x)], 1u);
    return b;
}
__device__ __forceinline__ void xcd_barrier_complete(unsigned* bar, unsigned x, unsigned& nloc, unsigned& nx) {
    const unsigned G = gridDim.x * gridDim.y * gridDim.z;
    unsigned sum, cnt, mine, sp = 0u;
    for (;;) {
        sum = 0u; cnt = 0u; mine = 0u;
#pragma unroll
        for (unsigned j = 0; j < 16; ++j) { const unsigned c = xb_ld(&bar[XB_XCNT(j)]); sum += c; cnt += (c > 0u) ? 1u : 0u; mine = (j == x) ? c : mine; }
        if (sum == G) break;
        __builtin_amdgcn_s_sleep(1);
        if ((++sp & 255u) == 0u) { if (xb_ld(&bar[XB_TMO])) break; if (sp > XB_SPIN_CAP) { atomicAdd(&bar[XB_TMO], 1u); break; } }
    }
    nloc = mine > 0u ? mine : 1u; nx = cnt > 0u ? cnt : 1u;
}

__device__ __forceinline__ void xcd_barrier(const XcdBarrier& b) {
    asm volatile("s_waitcnt vmcnt(0)" ::: "memory");
    __syncthreads();
    if (threadIdx.x == 0) {
        unsigned* bar = b.bar;
        __builtin_amdgcn_s_waitcnt(0);
        unsigned nloc = b.st[0], nx = b.st[1];
        if (nloc == 0u) { xcd_barrier_complete(bar, b.x, nloc, nx); b.st[0] = nloc; b.st[1] = nx; }
        const unsigned old = xb_add(&bar[XB_XSUB(b.x)], 1u);
        const unsigned gen = old / nloc;
        if (old + 1u == (gen + 1u) * nloc) {
            __builtin_amdgcn_fence(__ATOMIC_RELEASE, "agent");
            asm volatile("s_waitcnt vmcnt(0)" ::: "memory");
            const unsigned og = xb_add(&bar[XB_TOP], 1u);
            const unsigned tg = og / nx;
            if (og + 1u == (tg + 1u) * nx) xb_add(&bar[XB_TOPGEN], 1u);
            else XB_SPIN(xb_ld(&bar[XB_TOPGEN]) == tg, bar);
            __builtin_amdgcn_fence(__ATOMIC_ACQUIRE, "agent");
            xb_add(&bar[XB_XGEN(b.x)], 1u);
            asm volatile("s_waitcnt vmcnt(0)" ::: "memory");
        } else {
            XB_SPIN(xb_ld(&bar[XB_XGEN(b.x)]) == gen, bar);
            __builtin_amdgcn_fence(__ATOMIC_ACQUIRE, "agent");
            asm volatile("s_waitcnt vmcnt(0)" ::: "memory");
        }
    }
    __syncthreads();
}

namespace pg8 {
#define PG8_LAS __attribute__((address_space(3)))
typedef unsigned short bf16_t;
typedef short bf16x8 __attribute__((ext_vector_type(8)));
typedef float f32x4 __attribute__((ext_vector_type(4)));
typedef unsigned u32x4 __attribute__((ext_vector_type(4)));
constexpr int BM = 256, BK = 64, HALF = 128, HTB = HALF * BK * 2  , STAGE_BYTES = 8 * HTB, NXCD = 8, WGM = 8;

__host__ __device__ __forceinline__ int lds_byte(int r, int c) { const int st = (r >> 4) * 2 + (c >> 5), rr = r & 15, cc = c & 31, ob = rr * 64 + cc * 2; return st * 1024 + (ob ^ (((ob >> 9) & 1) << 5)); }
__host__ __device__ __forceinline__ void stage_rc(int b, int& R, int& C) { const int st = b / 1024, sb = b % 1024, swz = sb ^ (((sb >> 9) & 1) << 5); R = (st >> 1) * 16 + swz / 64; C = (st & 1) * 32 + (swz % 64) / 2; }
__host__ __device__ __forceinline__ int perm32(int rho) { const int n = rho >> 4, i = rho & 15; return 8 * (i >> 2) + 4 * n + (i & 3); }

struct Unit { int pm, pn; };
struct Gemm { const bf16_t* A; const bf16_t* Bt; int M, N, K; };

struct StaticOrder {
    int nM, nN, nwg, G, c;
    __host__ __device__ void init(int M, int N, int G_, int c_) { nM = M / BM; nN = N / BM; nwg = nM * nN; G = G_; c = c_; }
    __host__ __device__ bool next(int i, Unit& u) const {
        const long L = (long)i * G + c; if (L >= nwg) return false;
        int wgid = (int)L; { const int q = nwg / NXCD, r = nwg % NXCD, xcd = wgid % NXCD, off = wgid / NXCD; wgid = (xcd < r ? xcd * (q + 1) : r * (q + 1) + (xcd - r) * q) + off; }
        const int nig = WGM * nN, gid = wgid / nig, fm = gid * WGM, gsz = (nM - fm) < WGM ? (nM - fm) : WGM;
        u.pm = fm + ((wgid % nig) % gsz); u.pn = (wgid % nig) / gsz; return true;
    }
    __device__ __forceinline__ void a_ready(const Unit&) const {}
    __device__ __forceinline__ void done(const Unit&) const {}
};

template <class Epi, class Sched, bool STAMP = false>
__device__ __forceinline__ void gemm_phase(PG8_LAS unsigned char* lds, const Gemm g, const Sched& S, const Epi& E, unsigned long long* stamps) {
    const int tid = threadIdx.x, wid = __builtin_amdgcn_readfirstlane(tid >> 6), lane = tid & 63, wr = wid >> 2, wc = wid & 3, fr = lane & 15, fq = lane >> 4;
    const int K = g.K, nt = K / BK;
    int ts_lo = 0, ts_hi = 0, nts = 0; const unsigned long long rt_entry = STAMP ? (unsigned long long)wall_clock64() : 0ull;
#define PG8_STAMP() do { if (STAMP && wid == 0 && nts < 64) { const unsigned long long _c = (unsigned long long)clock64(); \
        ts_lo = (lane == nts) ? (int)(unsigned)_c : ts_lo; ts_hi = (lane == nts) ? (int)(unsigned)(_c >> 32) : ts_hi; ++nts; } } while (0)
    PG8_STAMP();
    unsigned voffA[2], voffB[2];
#pragma unroll
    for (int i = 0; i < 2; ++i) { int R, C; stage_rc(tid * 16 + i * 8192, R, C); const int Rb = Epi::PERM ? ((R & ~31) + perm32(R & 31)) : R;
        voffA[i] = (unsigned)(R * K + C) * 2u; voffB[i] = (unsigned)(Rb * K + C) * 2u; }
    const size_t kstep = (size_t)(BK * 2);
    const size_t hstep = (size_t)HALF * K * 2;
    const size_t tstep = 2 * hstep;
    const unsigned ldsw = (unsigned)wid * 1024u;
    const int aoff = lds_byte(wr * 64 + fr, fq * 8), boff = lds_byte(wc * 32 + fr, fq * 8);
#define PG8_SA(b, h) (((b) * 2 + (h)) * HTB)
#define PG8_SB(b, h) ((4 + (b) * 2 + (h)) * HTB)
#define PG8_STAGE(bufoff, gbase, voff) do { _Pragma("unroll") for (int _i = 0; _i < 2; ++_i) \
        __builtin_amdgcn_global_load_lds((const unsigned*)((const char*)(gbase) + (voff)[_i]), (PG8_LAS unsigned*)(lds + (bufoff) + ldsw + _i * 8192), 16, 0, 0); } while (0)
#define PG8_LDA(dst, b, h) do { _Pragma("unroll") for (int m = 0; m < 4; ++m) _Pragma("unroll") for (int k = 0; k < 2; ++k) dst[m][k] = *(const PG8_LAS bf16x8*)(lds + PG8_SA(b, h) + aoff + m * 2048 + k * 1024); } while (0)
#define PG8_LDB(dst, b, h) do { _Pragma("unroll") for (int n = 0; n < 2; ++n) _Pragma("unroll") for (int k = 0; k < 2; ++k) dst[n][k] = *(const PG8_LAS bf16x8*)(lds + PG8_SB(b, h) + boff + n * 2048 + k * 1024); } while (0)
#define PG8_MMA(ai, bj, At, Bt) do { __builtin_amdgcn_s_setprio(1); _Pragma("unroll") for (int m = 0; m < 4; ++m) _Pragma("unroll") for (int n = 0; n < 2; ++n) _Pragma("unroll") for (int k = 0; k < 2; ++k) \
        acc[ai][bj][m][n] = __builtin_amdgcn_mfma_f32_16x16x32_bf16(Bt[n][k], At[m][k], acc[ai][bj][m][n], 0, 0, 0); __builtin_amdgcn_s_setprio(0); } while (0)
#define PG8_WAIT_V(n) asm volatile("s_waitcnt vmcnt(" #n ")" ::: "memory")
#define PG8_WAIT_L(n) asm volatile("s_waitcnt lgkmcnt(" #n ")" ::: "memory")
#define PG8_BAR __builtin_amdgcn_s_barrier()
#define PG8_SCHED __builtin_amdgcn_sched_barrier(0)
    Unit cur, nxt; int ui = 0;
    if (!S.next(0, cur)) return;
    f32x4 acc[2][2][4][2];
#pragma unroll
    for (int a = 0; a < 2; ++a)
#pragma unroll
        for (int b = 0; b < 2; ++b)
#pragma unroll
            for (int m = 0; m < 4; ++m)
#pragma unroll
                for (int n = 0; n < 2; ++n) acc[a][b][m][n] = (f32x4){0.f, 0.f, 0.f, 0.f};
    bf16x8 At[4][2], B0[2][2], B1[2][2];
    const char* cA = (const char*)g.A + (size_t)cur.pm * tstep; const char* cB = (const char*)g.Bt + (size_t)cur.pn * tstep;
    S.a_ready(cur);
    PG8_STAGE(PG8_SB(0, 0), cB, voffB); PG8_STAGE(PG8_SA(0, 0), cA, voffA); PG8_STAGE(PG8_SB(0, 1), cB + hstep, voffB); PG8_STAGE(PG8_SA(0, 1), cA + hstep, voffA);
    if (wr == 1) PG8_BAR;
    PG8_WAIT_V(4); PG8_BAR;
    PG8_STAGE(PG8_SB(1, 0), cB + kstep, voffB); PG8_STAGE(PG8_SA(1, 0), cA + kstep, voffA); PG8_STAGE(PG8_SB(1, 1), cB + hstep + kstep, voffB);
    PG8_WAIT_V(6); PG8_BAR;
    PG8_STAMP();
    for (;;) {
        const bool has_next = S.next(ui + 1, nxt);
        const char* nA = has_next ? (const char*)g.A + (size_t)nxt.pm * tstep : cA; const char* nB = has_next ? (const char*)g.Bt + (size_t)nxt.pn * tstep : cB;
        for (int t = 0; t < nt; t += 2) {
            const bool last = (t == nt - 2);
            const char* a1 = cA + (size_t)(t + 1) * kstep;
            const char* a2 = last ? nA : cA + (size_t)(t + 2) * kstep; const char* b2 = last ? nB : cB + (size_t)(t + 2) * kstep;
            const char* a3 = a2 + kstep; const char* b3 = b2 + kstep;
            if (last && has_next) S.a_ready(nxt);
            PG8_LDB(B0, 0, 0); PG8_SCHED; PG8_LDA(At, 0, 0); PG8_STAGE(PG8_SA(1, 1), a1 + hstep, voffA);
            PG8_WAIT_L(8); PG8_BAR; PG8_WAIT_L(0); PG8_MMA(0, 0, At, B0); PG8_BAR; PG8_SCHED;
            PG8_LDB(B1, 0, 1); PG8_STAGE(PG8_SB(0, 0), b2, voffB);
            PG8_BAR; PG8_WAIT_L(0); PG8_MMA(0, 1, At, B1); PG8_BAR;
            PG8_LDA(At, 0, 1); PG8_STAGE(PG8_SA(0, 0), a2, voffA);
            PG8_BAR; PG8_WAIT_L(0); PG8_MMA(1, 0, At, B0); PG8_BAR; PG8_SCHED;
            PG8_STAGE(PG8_SB(0, 1), b2 + hstep, voffB);
            PG8_WAIT_V(6); PG8_BAR; PG8_MMA(1, 1, At, B1); PG8_BAR;
            PG8_LDB(B0, 1, 0); PG8_SCHED; PG8_LDA(At, 1, 0); PG8_STAGE(PG8_SA(0, 1), a2 + hstep, voffA);
            PG8_WAIT_L(8); PG8_BAR; PG8_WAIT_L(0); PG8_MMA(0, 0, At, B0); PG8_BAR; PG8_SCHED;
            PG8_LDB(B1, 1, 1); PG8_STAGE(PG8_SB(1, 0), b3, voffB);
            PG8_BAR; PG8_WAIT_L(0); PG8_MMA(0, 1, At, B1); PG8_BAR;
            PG8_LDA(At, 1, 1); PG8_STAGE(PG8_SA(1, 0), a3, voffA);
            PG8_BAR; PG8_WAIT_L(0); PG8_MMA(1, 0, At, B0); PG8_BAR; PG8_SCHED;
            PG8_STAGE(PG8_SB(1, 1), b3 + hstep, voffB);
            PG8_WAIT_V(6); PG8_BAR; PG8_MMA(1, 1, At, B1); PG8_BAR;
        }
        PG8_STAMP();
        if constexpr (!Epi::AFTER_DRAIN) { E(acc, cur, wr, wc, fr, fq); S.done(cur); }
        PG8_STAMP();
        if (!has_next) break;
#pragma unroll
        for (int a = 0; a < 2; ++a)
#pragma unroll
            for (int b = 0; b < 2; ++b)
#pragma unroll
                for (int m = 0; m < 4; ++m)
#pragma unroll
                    for (int n = 0; n < 2; ++n) acc[a][b][m][n] = (f32x4){0.f, 0.f, 0.f, 0.f};
        cur = nxt; cA = nA; cB = nB; ++ui;
    }
    PG8_WAIT_V(0);
    if (wr == 0) PG8_BAR;
    PG8_BAR;
    if constexpr (Epi::AFTER_DRAIN) { E.fused(acc, cur, wr, wc, fr, fq, lds, wid, lane); S.done(cur); }
    PG8_STAMP();
    if (STAMP && wid == 0) { stamps[lane] = lane < nts ? (((unsigned long long)(unsigned)ts_hi << 32) | (unsigned)ts_lo) : 0ull;
        if (lane == 62) stamps[62] = rt_entry; if (lane == 63) stamps[63] = (unsigned long long)wall_clock64(); }
#undef PG8_STAMP
#undef PG8_SA
#undef PG8_SB
#undef PG8_STAGE
#undef PG8_LDA
#undef PG8_LDB
#undef PG8_MMA
#undef PG8_WAIT_V
#undef PG8_WAIT_L
#undef PG8_BAR
#undef PG8_SCHED
}
}

struct EpiProj {
    static constexpr bool PERM = true, AFTER_DRAIN = false;
    bf16_t* O; int ldc; float* outK; float* outV; int kstart, vstart, kvw; const float* rope;
    __device__ __forceinline__ void operator()(const f32x4 (&acc)[2][2][4][2], const pg8::Unit& u, int wr, int wc, int fr, int fq) const {
        const int row0 = u.pm * 256 + wr * 64 + fr, colt = u.pn * 256, col0 = colt + wc * 32 + 8 * fq;
        const bool prompt = u.pm < (NP / 256);
        const bool do_rope = (rope != nullptr) && !prompt && colt < 2048;
        float* side = nullptr; int scol = 0;
        if (prompt) { if (colt >= kstart && colt < kstart + kvw) { side = outK; scol = col0 - kstart; } else if (colt >= vstart && colt < vstart + kvw) { side = outV; scol = col0 - vstart; } }
        const float sgn = fq < 2 ? -1.f : 1.f; const int fbase = (8 * fq) & 15;
#pragma unroll
        for (int ai = 0; ai < 2; ++ai)
#pragma unroll
            for (int m = 0; m < 4; ++m) {
                const int row = row0 + ai * 128 + m * 16;
                f32x4 cs0 = {1.f, 0.f, 1.f, 0.f}, cs1 = cs0, cs2 = cs0, cs3 = cs0;
                if (do_rope) { const int t = (row - NP) & (TS - 1); const int pos = (wc & 1) ? (t & 63) : (t >> 6); const f32x4* rp = (const f32x4*)(rope + (pos * 16 + fbase) * 2);
                    cs0 = rp[0]; cs1 = rp[1]; cs2 = rp[2]; cs3 = rp[3]; }
                bf16_t* rowp = O + (size_t)row * ldc + col0;
#pragma unroll
                for (int bj = 0; bj < 2; ++bj) {
                    f32x4 v0 = acc[ai][bj][m][0], v1 = acc[ai][bj][m][1];
                    if (do_rope) {
                        f32x4 p0, p1;
#pragma unroll
                        for (int j = 0; j < 4; ++j) { p0[j] = __shfl_xor(v0[j], 32); p1[j] = __shfl_xor(v1[j], 32); }
                        v0[0] = v0[0] * cs0[0] + sgn * p0[0] * cs0[1]; v0[1] = v0[1] * cs0[2] + sgn * p0[1] * cs0[3];
                        v0[2] = v0[2] * cs1[0] + sgn * p0[2] * cs1[1]; v0[3] = v0[3] * cs1[2] + sgn * p0[3] * cs1[3];
                        v1[0] = v1[0] * cs2[0] + sgn * p1[0] * cs2[1]; v1[1] = v1[1] * cs2[2] + sgn * p1[1] * cs2[3];
                        v1[2] = v1[2] * cs3[0] + sgn * p1[2] * cs3[1]; v1[3] = v1[3] * cs3[2] + sgn * p1[3] * cs3[3];
                    }
                    u32x4 w; w.x = cvt_pk_bf16(v0[0], v0[1]); w.y = cvt_pk_bf16(v0[2], v0[3]); w.z = cvt_pk_bf16(v1[0], v1[1]); w.w = cvt_pk_bf16(v1[2], v1[3]);
                    *(u32x4*)(rowp + bj * 128) = w;
                    if (side) { float* sp = side + (size_t)row * kvw + scol + bj * 128; *(f32x4*)sp = v0; *(f32x4*)(sp + 4) = v1; }
                }
            }
    }
};
struct EpiBf {
    static constexpr bool PERM = true, AFTER_DRAIN = false;
    bf16_t* O; int ldc;
    __device__ __forceinline__ void operator()(const f32x4 (&acc)[2][2][4][2], const pg8::Unit& u, int wr, int wc, int fr, int fq) const {
        const int row0 = u.pm * 256 + wr * 64 + fr, col0 = u.pn * 256 + wc * 32 + 8 * fq;
#pragma unroll
        for (int ai = 0; ai < 2; ++ai)
#pragma unroll
            for (int m = 0; m < 4; ++m) { bf16_t* rowp = O + (size_t)(row0 + ai * 128 + m * 16) * ldc + col0;
#pragma unroll
                for (int bj = 0; bj < 2; ++bj) { const f32x4 v0 = acc[ai][bj][m][0], v1 = acc[ai][bj][m][1];
                    u32x4 w; w.x = cvt_pk_bf16(v0[0], v0[1]); w.y = cvt_pk_bf16(v0[2], v0[3]); w.z = cvt_pk_bf16(v1[0], v1[1]); w.w = cvt_pk_bf16(v1[2], v1[3]);
                    *(u32x4*)(rowp + bj * 128) = w; } }
    }
};
struct EpiResid {
    static constexpr bool PERM = false, AFTER_DRAIN = false;
    const float* xin_p; const float* xin_s; float* xout; const float* gate;
    __device__ __forceinline__ void operator()(const f32x4 (&acc)[2][2][4][2], const pg8::Unit& u, int wr, int wc, int fr, int fq) const {
        const int row0 = u.pm * 256 + wr * 64 + fr, col0 = u.pn * 256 + wc * 32 + 4 * fq;
        const float* gp = gate + (size_t)cond_of_row(u.pm * 256) * 12288 + col0;
        f32x4 gv[2][2];
#pragma unroll
        for (int bj = 0; bj < 2; ++bj)
#pragma unroll
            for (int n = 0; n < 2; ++n) gv[bj][n] = *(const f32x4*)(gp + bj * 128 + n * 16);
#pragma unroll
        for (int ai = 0; ai < 2; ++ai) { f32x4 xi[4][2][2];
#pragma unroll
            for (int m = 0; m < 4; ++m) { const int row = row0 + ai * 128 + m * 16;
                const float* ip = (row < NP ? xin_p + (size_t)row * D : xin_s + (size_t)(row - NP) * D) + col0;
#pragma unroll
                for (int bj = 0; bj < 2; ++bj)
#pragma unroll
                    for (int n = 0; n < 2; ++n) xi[m][bj][n] = *(const f32x4*)(ip + bj * 128 + n * 16); }
            asm volatile("" ::: "memory");
#pragma unroll
            for (int m = 0; m < 4; ++m) { const int row = row0 + ai * 128 + m * 16; float* op = xout + (size_t)row * D + col0;
#pragma unroll
                for (int bj = 0; bj < 2; ++bj)
#pragma unroll
                    for (int n = 0; n < 2; ++n) *(f32x4*)(op + bj * 128 + n * 16) = xi[m][bj][n] + gv[bj][n] * acc[ai][bj][m][n]; } }
    }
};

DI void tr_tile_wave(const float* src, bf16_t* dst, int K, int N, int k0, int n0, LAS float* ts, int lane) {
    const int ty = lane >> 4, tx = lane & 15;
    f32x4 v[16];
#pragma unroll
    for (int i = 0; i < 16; ++i) v[i] = *(const f32x4*)(src + (size_t)(k0 + ty + 4 * i) * N + n0 + 4 * tx);
#pragma unroll
    for (int i = 0; i < 16; ++i) { const int k = ty + 4 * i; ts[k * 65 + 4 * tx + 0] = v[i][0]; ts[k * 65 + 4 * tx + 1] = v[i][1]; ts[k * 65 + 4 * tx + 2] = v[i][2]; ts[k * 65 + 4 * tx + 3] = v[i][3]; }
    __builtin_amdgcn_fence(__ATOMIC_ACQ_REL, "wavefront"); __builtin_amdgcn_wave_barrier();
    const int nl = lane >> 3, kc = (lane & 7) * 8;
#pragma unroll
    for (int g = 0; g < 8; ++g) { const int n = 8 * g + nl; float w[8];
#pragma unroll
        for (int j = 0; j < 8; ++j) w[j] = ts[(kc + j) * 65 + n];
        u32x4 pk; pk.x = cvt_pk_bf16(w[0], w[1]); pk.y = cvt_pk_bf16(w[2], w[3]); pk.z = cvt_pk_bf16(w[4], w[5]); pk.w = cvt_pk_bf16(w[6], w[7]);
        *(u32x4*)(dst + (size_t)(n0 + n) * K + k0 + kc) = pk; }
    __builtin_amdgcn_fence(__ATOMIC_ACQ_REL, "wavefront"); __builtin_amdgcn_wave_barrier();
}
DI void cvt_range(const float* src, bf16_t* dst, size_t n8, size_t gtid, size_t gstride) {
    for (size_t i = gtid; i < n8; i += gstride) { const f32x4 a = *(const f32x4*)(src + i * 8), b = *(const f32x4*)(src + i * 8 + 4);
        u32x4 w; w.x = cvt_pk_bf16(a[0], a[1]); w.y = cvt_pk_bf16(a[2], a[3]); w.z = cvt_pk_bf16(b[0], b[1]); w.w = cvt_pk_bf16(b[2], b[3]); *(u32x4*)(dst + i * 8) = w; }
}
DI void mod_unit(const Params& p, int u, LAS float* sl) {
    const int tid = threadIdx.x, lane = tid & 63, wave = tid >> 6;
    const int l = u / 384, cb = (u % 384) * 32, cl = tid & 7, ks = tid >> 3;
    for (int i = tid; i < 9 * 2048; i += NTHR) { const int c = i >> 11, k = i & 2047; const float v = (c == 0) ? p.c_ctx[k] : p.c[(c - 1) * 2048 + k]; sl[i] = v / (1.f + __expf(-v)); }
    __syncthreads();
    const float* W = p.w_mod + (size_t)l * 2048 * 12288 + cb + 4 * cl;
    float acc[9][4];
#pragma unroll
    for (int c = 0; c < 9; ++c)
#pragma unroll
        for (int j = 0; j < 4; ++j) acc[c][j] = 0.f;
#pragma unroll 4
    for (int kk = 0; kk < 32; ++kk) { const int k = kk * 64 + ks; const f32x4 w = *(const f32x4*)(W + (size_t)k * 12288);
#pragma unroll
        for (int c = 0; c < 9; ++c) { const float s = sl[c * 2048 + k];
#pragma unroll
            for (int j = 0; j < 4; ++j) acc[c][j] += s * w[j]; } }
#pragma unroll
    for (int c = 0; c < 9; ++c)
#pragma unroll
        for (int j = 0; j < 4; ++j) { float v = acc[c][j]; v += __shfl_xor(v, 8); v += __shfl_xor(v, 16); v += __shfl_xor(v, 32); acc[c][j] = v; }
    __syncthreads();
    LAS float* red = sl;
    if (lane < 8) {
#pragma unroll
        for (int c = 0; c < 9; ++c)
#pragma unroll
            for (int j = 0; j < 4; ++j) red[(wave * 9 + c) * 32 + cl * 4 + j] = acc[c][j]; }
    __syncthreads();
    if (tid < 288) { const int c = tid >> 5, col = tid & 31; float s = 0.f;
#pragma unroll
        for (int w = 0; w < 8; ++w) s += red[(w * 9 + c) * 32 + col];
        float* mod = (float*)(p.ws + WS_MOD);
        mod[(size_t)(l * 9 + c) * 12288 + cb + col] = s + p.b_mod[(size_t)l * 12288 + cb + col]; }
    __syncthreads();
}
constexpr int TR_T0 = 2560, TR_T1 = TR_T0 + 1024, TR_T2 = TR_T1 + 3072, TR_T3 = TR_T2 + 1024, TR_T4 = TR_T3 + 1024, TR_T5 = TR_T4 + 1024, TR_T6 = TR_T5 + 128;
constexpr int PRO_UNITS = TR_T6 + 768;

DI void prologue_phase(const Params& p, LAS unsigned char* lds) {
    const int tid = threadIdx.x;
    unsigned char* ws = p.ws;
    if (blockIdx.x == 0) {
        float* rope = (float*)(ws + WS_ROPE);
        for (int i = tid; i < 1024; i += NTHR) { const int pos = i >> 4, f = i & 15; const float inv = powf(10000.f, -(float)f / 16.f); const float ang = (float)pos * inv; rope[2 * i] = cosf(ang); rope[2 * i + 1] = sinf(ang); }
        if (tid < 64) { const float* lp = p.a_lambda; float a = lp[tid] * lp[64 + tid], b = lp[128 + tid] * lp[192 + tid]; a = wave_sum(a); b = wave_sum(b);
            if (tid == 0) ((float*)(ws + WS_SCAL))[0] = expf(a) - expf(b) + 0.2f; }
    }
    { const int lane = tid & 63, wave = tid >> 6;
      for (int u = blockIdx.x * NWAVES + wave; u < TR_T6; u += gridDim.x * NWAVES) {
          const float* src; bf16_t* dst; int K = 2048, N, t;
          if (u < TR_T0) { src = p.even_w_in; dst = (bf16_t*)(ws + WS_WEI); N = EVEN_IN; t = u; }
          else if (u < TR_T1) { src = p.even_w_out; dst = (bf16_t*)(ws + WS_WEO); N = D; t = u - TR_T0; }
          else if (u < TR_T2) { src = p.odd_w_in; dst = (bf16_t*)(ws + WS_WOI); N = ODD_IN; t = u - TR_T1; }
          else if (u < TR_T3) { src = p.odd_w_out; dst = (bf16_t*)(ws + WS_WOO); N = D; t = u - TR_T2; }
          else if (u < TR_T4) { src = p.peer_w_q; dst = (bf16_t*)(ws + WS_WPQ); N = D; t = u - TR_T3; }
          else if (u < TR_T5) { src = p.peer_w_q + (size_t)D * D; dst = (bf16_t*)(ws + WS_WPQ) + (size_t)D * D; N = D; t = u - TR_T4; }
          else { t = u - TR_T5; const int mat = t >> 2; t &= 3; const int kind = mat >> 4, rest = mat & 15;
              src = (kind ? p.lru_w_i : p.lru_w_a) + (size_t)rest * 128 * 128; dst = (bf16_t*)(ws + WS_LRW) + (size_t)mat * 128 * 128; K = 128; N = 128; }
          const int ntn = N / 64; const int tk = t / ntn, tn = t % ntn;
          tr_tile_wave(src, dst, K, N, tk * 64, tn * 64, (LAS float*)lds + wave * (64 * 65), lane);
      } }
    __syncthreads();
    for (int u = blockIdx.x; u < PRO_UNITS - TR_T6; u += gridDim.x) mod_unit(p, u, (LAS float*)lds);
    const size_t gtid = (size_t)blockIdx.x * NTHR + tid, gstride = (size_t)gridDim.x * NTHR;
    cvt_range(p.peer_sub_keys, (bf16_t*)(ws + WS_SK), (size_t)2 * 8 * 2 * 128 * 128 / 8, gtid, gstride);
    cvt_range(p.cache_a_k, (bf16_t*)(ws + WS_CAK), (size_t)8 * 512 * 1024 / 8, gtid, gstride);
    cvt_range(p.cache_a_v, (bf16_t*)(ws + WS_CAV), (size_t)8 * 512 * 1024 / 8, gtid, gstride);
    cvt_range(p.cache_c_k, (bf16_t*)(ws + WS_CCK), (size_t)8 * 512 * 2048 / 8, gtid, gstride);
    cvt_range(p.cache_c_v, (bf16_t*)(ws + WS_CCV), (size_t)8 * 512 * 2048 / 8, gtid, gstride);
    { const int lane = tid & 63, wave = tid >> 6;
      bool interleaved;
      { f32x16 pa, pb;
#pragma unroll
        for (int i = 0; i < 16; ++i) { pa[i] = 0.125f * (float)i; pb[i] = i < 8 ? 2.f + 0.25f * (float)i : 4.f + 0.5f * (float)(i - 8); }
        const f32x32 d = __builtin_amdgcn_cvt_scalef32_pk32_f32_fp6(__builtin_amdgcn_cvt_scalef32_2xpk16_fp6_f32(pa, pb, 1.0f), 1.0f);
        interleaved = (d[1] != 0.125f); }
      for (int rw = blockIdx.x * NWAVES + wave; rw < 4 * PEER_N; rw += gridDim.x * NWAVES) {
          const int tbl = rw >> 15, r = rw & 32767;
          const float* src = (tbl ? p.peer_v : p.peer_u) + (size_t)r * D + 32 * lane;
          f32x4 x[8]; float am = 0.f;
#pragma unroll
          for (int q = 0; q < 8; ++q) { x[q] = *(const f32x4*)(src + 4 * q);
#pragma unroll
              for (int j = 0; j < 4; ++j) am = fmaxf(am, fabsf(x[q][j])); }
          am = fmaxf(am, __shfl_xor(am, 1)); am = fmaxf(am, __shfl_xor(am, 2)); am = fmaxf(am, __shfl_xor(am, 4)); am = fmaxf(am, __shfl_xor(am, 8)); am = fmaxf(am, __shfl_xor(am, 16)); am = fmaxf(am, __shfl_xor(am, 32));
          const float inv = am > 0.f ? 7.5f / am : 0.f;
          f32x16 a, b;
          if (!interleaved) {
#pragma unroll
              for (int i = 0; i < 16; ++i) { a[i] = x[i >> 2][i & 3] * inv; b[i] = x[4 + (i >> 2)][i & 3] * inv; }
          } else {
#pragma unroll
              for (int i = 0; i < 16; ++i) { a[i] = x[(2 * i) >> 2][(2 * i) & 3] * inv; b[i] = x[(2 * i + 1) >> 2][(2 * i + 1) & 3] * inv; }
          }
          const u32x6 pk = __builtin_amdgcn_cvt_scalef32_2xpk16_fp6_f32(a, b, 1.0f);
          unsigned char* dst = ws + (tbl ? WS_PV : WS_PU) + (size_t)r * PROW + 24 * lane;
          *(u32x2*)dst = (u32x2){pk[0], pk[1]}; *(u32x2*)(dst + 8) = (u32x2){pk[2], pk[3]}; *(u32x2*)(dst + 16) = (u32x2){pk[4], pk[5]};
          if (lane == 0) ((float*)(ws + (tbl ? WS_PSV : WS_PSU)))[r] = am > 0.f ? am * (1.f / 7.5f) : 1.f;
      } }
}

DI void norm_row_store(const f32x4 (&x)[4][2], const float* g, const float* shift, const float* scale, bf16_t* hrow, int lane) {
    float ss = 0.f;
#pragma unroll
    for (int k = 0; k < 4; ++k)
#pragma unroll
        for (int q = 0; q < 2; ++q)
#pragma unroll
            for (int j = 0; j < 4; ++j) ss += x[k][q][j] * x[k][q][j];
    ss = wave_sum(ss);
    const float rs = rsqrtf(ss * (1.f / 2048.f) + 1e-6f);
#pragma unroll
    for (int k = 0; k < 4; ++k) { const int e = 512 * k + 8 * lane; float y[8];
#pragma unroll
        for (int q = 0; q < 2; ++q) { const f32x4 gv = *(const f32x4*)(g + e + 4 * q), sc = *(const f32x4*)(scale + e + 4 * q), sh = *(const f32x4*)(shift + e + 4 * q);
#pragma unroll
            for (int j = 0; j < 4; ++j) y[4 * q + j] = x[k][q][j] * rs * gv[j] * (1.f + sc[j]) + sh[j]; }
        u32x4 w; w.x = cvt_pk_bf16(y[0], y[1]); w.y = cvt_pk_bf16(y[2], y[3]); w.z = cvt_pk_bf16(y[4], y[5]); w.w = cvt_pk_bf16(y[6], y[7]);
        *(u32x4*)(hrow + e) = w; }
}
template <bool FIRST> DI void norm_phase(const Params& p, int l, int which) {
    const int tid = threadIdx.x, lane = tid & 63, wave = tid >> 6;
    const float* mod = (const float*)(p.ws + WS_MOD) + (size_t)l * 9 * 12288;
    const float* g = (which ? p.norm2_g : p.norm1_g) + l * D;
    bf16_t* h = (bf16_t*)(p.ws + WS_H);
    const float* xres = p.out + OUT_YP;
    constexpr int RPW = NTOK / (256 * NWAVES);
    int cached = -1; f32x4 gs[4][2], sh[4][2];
    for (int gw = blockIdx.x * NWAVES + wave; gw * RPW < NTOK; gw += gridDim.x * NWAVES)
        for (int i = 0; i < RPW; ++i) { const int row = gw * RPW + i;
            const float* xr = FIRST ? (row < NP ? p.x_prompt + (size_t)row * D : p.x_sample + (size_t)(row - NP) * D) : xres + (size_t)row * D;
            f32x4 x[4][2];
#pragma unroll
            for (int k = 0; k < 4; ++k)
#pragma unroll
                for (int q = 0; q < 2; ++q) x[k][q] = *(const f32x4*)(xr + 512 * k + 8 * lane + 4 * q);
            const int cond = cond_of_row(row);
            if (cond != cached) { cached = cond; const float* mc = mod + (size_t)cond * 12288 + which * 3 * D;
#pragma unroll
                for (int k = 0; k < 4; ++k)
#pragma unroll
                    for (int q = 0; q < 2; ++q) { const int e = 512 * k + 8 * lane + 4 * q; const f32x4 gv = *(const f32x4*)(g + e), sc = *(const f32x4*)(mc + D + e); sh[k][q] = *(const f32x4*)(mc + e);
#pragma unroll
                        for (int j = 0; j < 4; ++j) gs[k][q][j] = gv[j] * (1.f + sc[j]); } }
            float ss = 0.f;
#pragma unroll
            for (int k = 0; k < 4; ++k)
#pragma unroll
                for (int q = 0; q < 2; ++q)
#pragma unroll
                    for (int j = 0; j < 4; ++j) ss += x[k][q][j] * x[k][q][j];
            ss = wave_sum(ss);
            const float rs = rsqrtf(ss * (1.f / 2048.f) + 1e-6f);
#pragma unroll
            for (int k = 0; k < 4; ++k) { float y[8];
#pragma unroll
                for (int q = 0; q < 2; ++q)
#pragma unroll
                    for (int j = 0; j < 4; ++j) y[4 * q + j] = x[k][q][j] * rs * gs[k][q][j] + sh[k][q][j];
                u32x4 w; w.x = cvt_pk_bf16(y[0], y[1]); w.y = cvt_pk_bf16(y[2], y[3]); w.z = cvt_pk_bf16(y[4], y[5]); w.w = cvt_pk_bf16(y[6], y[7]);
                *(u32x4*)(h + (size_t)row * D + 512 * k + 8 * lane) = w; }
        }
}

constexpr int KT_BYTES = 16384, VT_BYTES = 16384, ATT_BUF = KT_BYTES + VT_BYTES;
constexpr int ATT_RPB = 2 * ATT_BUF;
#define MFMA32(a, b, c) __builtin_amdgcn_mfma_f32_32x32x16_bf16((a), (b), (c), 0, 0, 0)
struct AttnArgs {
    const bf16_t* Q; int ldq;
    const bf16_t* K0; const bf16_t* V0; int n0, ld0;
    const bf16_t* K1; const bf16_t* V1; int n1, ld1;
    bf16_t* O; int ldo;
    float C;
    float lam; const float* subg;
    const float* rpb; int qr0, krlo;
};
DI void att_dma(const AttnArgs& a, int j, LAS unsigned char* buf, int wave, int lane) {
    int key0 = j * 64; const bf16_t* K = a.K0; const bf16_t* V = a.V0; int ld = a.ld0;
    if (key0 >= a.n0) { key0 -= a.n0; K = a.K1; V = a.V1; ld = a.ld1; }
    const int sub = lane >> 5, rr = (lane >> 2) & 7, cp = lane & 3;
#pragma unroll
    for (int i = 0; i < 2; ++i) { const int pc = 2 * wave + i, R = pc >> 1, Cp = pc & 1;
        const int row = 8 * R + rr, ch = 4 * (2 * Cp + sub) + (cp ^ ((2 * R + (rr >> 2)) & 3));
        const size_t off = (size_t)(key0 + row) * ld + ch * 8;
        __builtin_amdgcn_global_load_lds((const unsigned*)(K + off), (LAS unsigned*)(buf + pc * 1024), 16, 0, 0);
        __builtin_amdgcn_global_load_lds((const unsigned*)(V + off), (LAS unsigned*)(buf + KT_BYTES + pc * 1024), 16, 0, 0); }
}
DI bf16x8 pack8(const f32x16& x, int s) {
    u32x4 w; w.x = cvt_pk_bf16(x[8 * s + 0], x[8 * s + 1]); w.y = cvt_pk_bf16(x[8 * s + 2], x[8 * s + 3]); w.z = cvt_pk_bf16(x[8 * s + 4], x[8 * s + 5]); w.w = cvt_pk_bf16(x[8 * s + 6], x[8 * s + 7]);
    return __builtin_bit_cast(bf16x8, w);
}
template <int MODE> DI void attn_unit(LAS unsigned char* lds, const AttnArgs& a) {
    const int tid = threadIdx.x, lane = tid & 63, wave = __builtin_amdgcn_readfirstlane(tid >> 6), r = lane & 31, h = lane >> 5;
    constexpr int NKS = MODE == 0 ? 4 : 8;
    const int qloc = MODE == 0 ? 32 * (wave >> 1) + r : 32 * wave + r;
    const int kofs = MODE == 0 ? 64 * (wave & 1) : 0;
    bf16x8 qf[NKS];
    { const bf16_t* qp = a.Q + (size_t)qloc * a.ldq + kofs + 8 * h;
#pragma unroll
      for (int ks = 0; ks < NKS; ++ks) qf[ks] = *(const bf16x8*)(qp + 16 * ks); }
    if (MODE == 2) { for (int i = tid; i < 465; i += NTHR) ((LAS float*)(lds + ATT_RPB))[i] = a.rpb[i] * 1.4426950408889634f; }
    f32x16 o[4];
#pragma unroll
    for (int d4 = 0; d4 < 4; ++d4)
#pragma unroll
        for (int i = 0; i < 16; ++i) o[d4][i] = 0.f;
    float m = -1e30f, l = 0.f;
    const int ntiles = (a.n0 + a.n1) >> 6;
    att_dma(a, 0, lds, wave, lane);
    asm volatile("s_waitcnt vmcnt(0)" ::: "memory");
    __syncthreads();
    int qr = 0, qc = 0, cs = 0, rs = 0;
    if (MODE == 2) { qr = a.qr0 + (wave >> 1); qc = 32 * (wave & 1) + r; cs = min(max(qc - 8, 0), 48); rs = min(max(qr - 4, 0), 56); }
    const int kb0 = 2048 * (r >> 3) + 64 * (r & 7) + 512 * (kofs >> 5);
    const int kbase0 = kb0 + 16 * ((0 + h) ^ ((r >> 2) & 3)), kbase1 = kb0 + 16 * ((2 + h) ^ ((r >> 2) & 3));
    const int tblk = (lane >> 4) & 1, tq = (lane & 15) >> 2, tp = lane & 3;
    const int vb0 = 64 * (4 * h + tq) + 8 * (tp & 1);
    const int vbase0 = vb0 + 16 * ((2 * tblk + (tp >> 1)) ^ ((0 + h) & 3)), vbase1 = vb0 + 2048 + 16 * ((2 * tblk + (tp >> 1)) ^ ((2 + h) & 3));
    for (int j = 0; j < ntiles; ++j) {
        LAS unsigned char* buf = lds + (j & 1) * ATT_BUF;
        if (j + 1 < ntiles) att_dma(a, j + 1, lds + ((j + 1) & 1) * ATT_BUF, wave, lane);
        bool active = true; int kr = 0;
        if (MODE == 2 && j >= 8) { kr = a.krlo + (j - 8); const int wrs = min(max(a.qr0 + (wave >> 1) - 4, 0), 56); active = (kr >= wrs) && (kr < wrs + 8); }
        if (active) {
            f32x16 s0, s1;
#pragma unroll
            for (int i = 0; i < 16; ++i) { s0[i] = 0.f; s1[i] = 0.f; }
#pragma unroll
            for (int ks = 0; ks < NKS; ++ks) { const LAS unsigned char* kp = buf + ((ks & 1) ? kbase1 : kbase0) + 512 * (ks >> 1);
                const bf16x8 k0 = *(const LAS bf16x8*)kp, k1 = *(const LAS bf16x8*)(kp + 8192);
                s0 = MFMA32(k0, qf[ks], s0); s1 = MFMA32(k1, qf[ks], s1); }
            if (MODE == 2) {
#pragma unroll
                for (int i = 0; i < 16; ++i) { s0[i] *= a.C; s1[i] *= a.C; }
                if (j >= 8) {
                    const LAS float* rp = (const LAS float*)(lds + ATT_RPB) + (kr - qr + 7) * 31 + 15 - qc;
#pragma unroll
                    for (int i = 0; i < 16; ++i) { const int kc = (i & 3) + 8 * (i >> 2) + 4 * h;
                        s0[i] = (kc >= cs && kc < cs + 16) ? s0[i] + rp[kc] : -INFINITY;
                        s1[i] = (kc + 32 >= cs && kc + 32 < cs + 16) ? s1[i] + rp[kc + 32] : -INFINITY; }
                }
            }
            const float Ce = MODE == 2 ? 1.f : a.C;
            float mx = fmaxf(s0[0], s1[0]);
#pragma unroll
            for (int i = 1; i < 16; ++i) mx = fmaxf(mx, fmaxf(s0[i], s1[i]));
            mx = fmaxf(mx, __shfl_xor(mx, 32)) * Ce;
            if (!__all(mx <= m + 8.f)) {
                const float mn = fmaxf(m, mx), alpha = __builtin_amdgcn_exp2f(m - mn); m = mn; l *= alpha;
#pragma unroll
                for (int d4 = 0; d4 < 4; ++d4)
#pragma unroll
                    for (int i = 0; i < 16; ++i) o[d4][i] *= alpha;
            }
            float ps = 0.f;
#pragma unroll
            for (int i = 0; i < 16; ++i) { s0[i] = __builtin_amdgcn_exp2f(fmaf(s0[i], Ce, -m)); s1[i] = __builtin_amdgcn_exp2f(fmaf(s1[i], Ce, -m)); ps += s0[i] + s1[i]; }
            l += ps;
            bf16x8 pf[4]; pf[0] = pack8(s0, 0); pf[1] = pack8(s0, 1); pf[2] = pack8(s1, 0); pf[3] = pack8(s1, 1);
            const LAS unsigned char* vp0 = buf + KT_BYTES + vbase0; const LAS unsigned char* vp1 = buf + KT_BYTES + vbase1;
#pragma unroll
            for (int kk = 0; kk < 4; ++kk)
#pragma unroll
                for (int d4 = 0; d4 < 4; ++d4) {
                    const s16x4 lo = __builtin_amdgcn_ds_read_tr16_b64_v4i16((LAS s16x4*)(vp0 + 4096 * kk + 512 * d4));
                    const s16x4 hi = __builtin_amdgcn_ds_read_tr16_b64_v4i16((LAS s16x4*)(vp1 + 4096 * kk + 512 * d4));
                    bf16x8 vf; vf[0] = lo[0]; vf[1] = lo[1]; vf[2] = lo[2]; vf[3] = lo[3]; vf[4] = hi[0]; vf[5] = hi[1]; vf[6] = hi[2]; vf[7] = hi[3];
                    o[d4] = MFMA32(vf, pf[kk], o[d4]);
                }
        }
        asm volatile("s_waitcnt vmcnt(0)" ::: "memory");
        __syncthreads();
    }
    l += __shfl_xor(l, 32);
    const float inv = 1.f / l;
    if (MODE != 0) {
        bf16_t* op = a.O + (size_t)qloc * a.ldo + 4 * h;
#pragma unroll
        for (int d4 = 0; d4 < 4; ++d4)
#pragma unroll
            for (int g4 = 0; g4 < 4; ++g4) { u32x2 w; w.x = cvt_pk_bf16(o[d4][4 * g4] * inv, o[d4][4 * g4 + 1] * inv); w.y = cvt_pk_bf16(o[d4][4 * g4 + 2] * inv, o[d4][4 * g4 + 3] * inv);
                *(u32x2*)(op + 32 * d4 + 8 * g4) = w; }
    } else {
        LAS float* ex = (LAS float*)lds + qloc * 132 + 4 * h;
        if (wave & 1) {
#pragma unroll
            for (int d4 = 0; d4 < 4; ++d4)
#pragma unroll
                for (int g4 = 0; g4 < 4; ++g4) { f32x4 v; v[0] = o[d4][4 * g4] * inv; v[1] = o[d4][4 * g4 + 1] * inv; v[2] = o[d4][4 * g4 + 2] * inv; v[3] = o[d4][4 * g4 + 3] * inv; *(LAS f32x4*)(ex + 32 * d4 + 8 * g4) = v; }
        }
        __syncthreads();
        if (!(wave & 1)) {
            float ss = 0.f;
#pragma unroll
            for (int d4 = 0; d4 < 4; ++d4)
#pragma unroll
                for (int g4 = 0; g4 < 4; ++g4) { const f32x4 o1 = *(const LAS f32x4*)(ex + 32 * d4 + 8 * g4);
#pragma unroll
                    for (int e = 0; e < 4; ++e) { const float v = o[d4][4 * g4 + e] * inv - a.lam * o1[e]; o[d4][4 * g4 + e] = v; ss += v * v; } }
            ss += __shfl_xor(ss, 32);
            const float rsn = rsqrtf(ss * (1.f / 128.f) + 1e-6f) * 0.8f;
            bf16_t* op = a.O + (size_t)qloc * a.ldo + 4 * h;
#pragma unroll
            for (int d4 = 0; d4 < 4; ++d4)
#pragma unroll
                for (int g4 = 0; g4 < 4; ++g4) { const f32x4 gv = *(const f32x4*)(a.subg + 32 * d4 + 8 * g4 + 4 * h);
                    u32x2 w; w.x = cvt_pk_bf16(o[d4][4 * g4] * rsn * gv[0], o[d4][4 * g4 + 1] * rsn * gv[1]); w.y = cvt_pk_bf16(o[d4][4 * g4 + 2] * rsn * gv[2], o[d4][4 * g4 + 3] * rsn * gv[3]);
                    *(u32x2*)(op + 32 * d4 + 8 * g4) = w; }
        }
        __syncthreads();
    }
}
DI int q_next(unsigned* ctr, volatile LAS unsigned* misc) {
    __syncthreads();
    if (threadIdx.x == 0) misc[0] = __hip_atomic_fetch_add(ctr, 1u, __ATOMIC_RELAXED, __HIP_MEMORY_SCOPE_AGENT);
    __syncthreads();
    return (int)misc[0];
}

constexpr int LR_W = 0;
constexpr int LR_WK = 128 * 272;
constexpr int LR_XR = LR_W + 2 * LR_WK;
constexpr int LR_XCB = LR_XR + 9216;
constexpr int LR_XC = LR_XCB + 32 * 272;
constexpr int LR_AS = LR_XC + 32 * 132 * 4;
constexpr int LR_BS = LR_AS + 32 * 144 * 4;
constexpr int LR_CAR = LR_BS + 32 * 144 * 4;
constexpr int LR_HC = LR_CAR + 4 * 128 * 8;
constexpr int LR_END = LR_HC + 512;
static_assert(LR_END <= LDS_MISC, "LRU LDS map");
#define MFMA16(a, b, c) __builtin_amdgcn_mfma_f32_16x16x32_bf16((a), (b), (c), 0, 0, 0)

DI float fast_sigmoid(float x) { return __builtin_amdgcn_rcpf(1.f + __builtin_amdgcn_exp2f(-1.4426950408889634f * x)); }
DI void lru_unit(const Params& p, LAS unsigned char* lds, int seq, int blk) {
    const int tid = threadIdx.x, lane = tid & 63, wave = __builtin_amdgcn_readfirstlane(tid >> 6);
    const int T = seq < 32 ? TP : TS, tb = seq < 32 ? seq * TP : NP + (seq - 32) * TS, c0 = blk * 128;
    const bf16_t* proj = (const bf16_t*)(p.ws + WS_PROJ);
    float* HF = (float*)(p.ws + WS_H);
    bf16_t* mix = (bf16_t*)(p.ws + WS_MIX);
    const bf16_t* lrw = (const bf16_t*)(p.ws + WS_LRW);
    const int c = tid & 127, sub = tid >> 7;
    float cw[4];
#pragma unroll
    for (int j = 0; j < 4; ++j) cw[j] = p.lru_conv_w[j * 1024 + c0 + c];
    const float cb = p.lru_conv_b[c0 + c];
    const int tbk = wave & 1, cg = wave >> 1, fr = lane & 15, fq = lane >> 4;
    LAS float* HC = (LAS float*)(lds + LR_HC);
    for (int dir = 0; dir < 2; ++dir) {
        __syncthreads();
#pragma unroll
        for (int i = 0; i < 8; ++i) { const int ch = tid + 512 * i, kind = ch >> 11, rem = ch & 2047, o = rem >> 4, cc = rem & 15;
            const u32x4 w = *(const u32x4*)(lrw + ((size_t)((kind * 2 + dir) * 8 + blk) * 128 + o) * 128 + cc * 8);
            *(LAS u32x4*)(lds + LR_W + kind * LR_WK + o * 272 + cc * 16) = w; }
        float ba[2], bi[2], nsp[2];
#pragma unroll
        for (int cbk = 0; cbk < 2; ++cbk) { const int o = c0 + 32 * cg + 16 * cbk + fr; ba[cbk] = p.lru_b_a[dir * 1024 + o]; bi[cbk] = p.lru_b_i[dir * 1024 + o];
            const float lam = p.lru_lambda[dir * 1024 + o]; const float sp = (-lam > 20.f) ? -lam : log1pf(__expf(-lam)); nsp[cbk] = -8.f * sp * 1.4426950408889634f; }
        if (tid < 128) HC[tid] = (seq >= 32) ? p.state_lru[(size_t)(seq - 32) * 2048 + dir * 1024 + c0 + tid] : 0.f;
        const int nch = T / 32;
        u32x4 xrn[2];
        auto ld_xr = [&](int t0) {
#pragma unroll
            for (int i = 0; i < 2; ++i) { const int ch = tid + 512 * i, row = ch >> 4, cc = ch & 15, t = t0 - 2 + row; u32x4 v = {0u, 0u, 0u, 0u};
                if (ch < 560 && t >= 0 && t < T) v = *(const u32x4*)(proj + (size_t)(tb + t) * EVEN_IN + 3072 + c0 + cc * 8);
                xrn[i] = v; } };
        ld_xr(dir ? T - 32 : 0);
        for (int chk = 0; chk < nch; ++chk) {
            const int t0 = dir ? T - 32 - 32 * chk : 32 * chk;
#pragma unroll
            for (int i = 0; i < 2; ++i) { const int ch = tid + 512 * i; if (ch < 560) *(LAS u32x4*)(lds + LR_XR + ch * 16) = xrn[i]; }
            if (chk + 1 < nch) ld_xr(dir ? t0 - 32 : t0 + 32);
            float hfv[8]; unsigned short gv[8];
            if (dir) {
#pragma unroll
                for (int i = 0; i < 8; ++i) { const int tl = 31 - (8 * sub + i); const size_t tok = (size_t)(tb + t0 + tl);
                    hfv[i] = HF[tok * 1024 + c0 + c]; gv[i] = proj[tok * EVEN_IN + 4096 + c0 + c]; } }
            __syncthreads();
            { const LAS bf16_t* xr = (const LAS bf16_t*)(lds + LR_XR);
#pragma unroll
              for (int i = 0; i < 8; ++i) { const int tl = 8 * sub + i; float acc = cb;
#pragma unroll
                  for (int j = 0; j < 4; ++j) acc += cw[j] * __uint_as_float(((unsigned)xr[(tl + j) * 128 + c]) << 16);
                  ((LAS float*)(lds + LR_XC))[tl * 132 + c] = acc;
                  ((LAS bf16_t*)(lds + LR_XCB))[tl * 136 + c] = (bf16_t)(cvt_pk_bf16(acc, 0.f) & 0xffffu); } }
            __syncthreads();
            { f32x4 acc[2][2];
#pragma unroll
              for (int k = 0; k < 2; ++k)
#pragma unroll
                  for (int cbk = 0; cbk < 2; ++cbk) acc[k][cbk] = (f32x4){0.f, 0.f, 0.f, 0.f};
#pragma unroll
              for (int ks = 0; ks < 4; ++ks) { const bf16x8 af = *(const LAS bf16x8*)(lds + LR_XCB + (16 * tbk + fr) * 272 + (32 * ks + 8 * fq) * 2);
#pragma unroll
                  for (int k = 0; k < 2; ++k)
#pragma unroll
                      for (int cbk = 0; cbk < 2; ++cbk) { const bf16x8 bf = *(const LAS bf16x8*)(lds + LR_W + k * LR_WK + (32 * cg + 16 * cbk + fr) * 272 + (32 * ks + 8 * fq) * 2);
                          acc[k][cbk] = MFMA16(af, bf, acc[k][cbk]); } }
#pragma unroll
              for (int cbk = 0; cbk < 2; ++cbk)
#pragma unroll
                  for (int rg = 0; rg < 4; ++rg) { const int tl = 16 * tbk + 4 * fq + rg, o = 32 * cg + 16 * cbk + fr;
                      const float rr = fast_sigmoid(acc[0][cbk][rg] + ba[cbk]), ii = fast_sigmoid(acc[1][cbk][rg] + bi[cbk]);
                      const float la = rr * nsp[cbk], av = __builtin_amdgcn_exp2f(la), xc = ((const LAS float*)(lds + LR_XC))[tl * 132 + o];
                      const float bv = __builtin_amdgcn_sqrtf(fmaxf((1.f - av) * (1.f + av), 0.f)) * ii * xc;
                      ((LAS float*)(lds + LR_AS))[tl * 144 + o] = av; ((LAS float*)(lds + LR_BS))[tl * 144 + o] = bv; } }
            __syncthreads();
            float hl[8], Pv[8];
            { float hh = 0.f, P = 1.f;
#pragma unroll
              for (int i = 0; i < 8; ++i) { const int u = 8 * sub + i, tl = dir ? 31 - u : u; const float av = ((const LAS float*)(lds + LR_AS))[tl * 144 + c], bv = ((const LAS float*)(lds + LR_BS))[tl * 144 + c];
                  hh = av * hh + bv; P *= av; hl[i] = hh; Pv[i] = P; }
              *(LAS f32x2*)(lds + LR_CAR + (sub * 128 + c) * 8) = (f32x2){P, hh}; }
            __syncthreads();
            float hin = HC[c];
#pragma unroll
            for (int s = 0; s < 3; ++s) if (s < sub) { const f32x2 e = *(const LAS f32x2*)(lds + LR_CAR + (s * 128 + c) * 8); hin = e[0] * hin + e[1]; }
            float hv[8];
#pragma unroll
            for (int i = 0; i < 8; ++i) hv[i] = hl[i] + Pv[i] * hin;
            __syncthreads();
            if (sub == 3) HC[c] = hv[7];
            if (!dir) {
#pragma unroll
                for (int i = 0; i < 8; ++i) { const int tl = 8 * sub + i; HF[(size_t)(tb + t0 + tl) * 1024 + c0 + c] = hv[i]; }
            } else {
#pragma unroll
                for (int i = 0; i < 8; ++i) { const int tl = 31 - (8 * sub + i); const float g = __uint_as_float(((unsigned)gv[i]) << 16);
                    const float ov = (hfv[i] + hv[i]) * gelu_tanh(g);
                    mix[(size_t)(tb + t0 + tl) * D + 1024 + c0 + c] = (bf16_t)(cvt_pk_bf16(ov, 0.f) & 0xffffu); }
            }
        }
        __syncthreads();
        if (seq < 32 && tid < 128) p.out[OUT_LRU + (size_t)seq * 2048 + dir * 1024 + c0 + tid] = HC[tid];
    }
    __syncthreads();
}

constexpr int PS_ROW = 129;
#define PS_WAVE_SYNC() do { __builtin_amdgcn_fence(__ATOMIC_ACQ_REL, "wavefront"); __builtin_amdgcn_wave_barrier(); } while (0)
#define PS_INSERT(tv, v) do { _Pragma("unroll") for (int _i = 15; _i >= 1; --_i) tv[_i] = __builtin_amdgcn_fmed3f(tv[_i - 1], tv[_i], (v)); tv[0] = fmaxf(tv[0], (v)); } while (0)
DI void peer_select_phase(const Params& p, int l, LAS unsigned char* lds) {
    const int tid = threadIdx.x, lane = tid & 63, wave = __builtin_amdgcn_readfirstlane(tid >> 6), fr = lane & 15, fq = lane >> 4;
    const bf16_t* qp = (const bf16_t*)(p.ws + WS_MIX);
    const bf16_t* skl = (const bf16_t*)(p.ws + WS_SK) + (size_t)l * 8 * 2 * 128 * 128;
    int* pidx = (int*)(p.ws + WS_PIDX); float* pgate = (float*)(p.ws + WS_PGATE);
    LAS float* SCw = (LAS float*)lds + wave * (32 * PS_ROW);
    for (int u = blockIdx.x; u < 1280; u += gridDim.x) {
        const int head = u / 160, tile = u % 160, tw = tile * 256 + 32 * wave;
        float alist[16], blist[16];
#pragma unroll
        for (int pp = 0; pp < 2; ++pp) {
            f32x4 acc[2][8];
#pragma unroll
            for (int g = 0; g < 2; ++g)
#pragma unroll
                for (int kb = 0; kb < 8; ++kb) acc[g][kb] = (f32x4){0.f, 0.f, 0.f, 0.f};
            const bf16_t* qrow = qp + (size_t)(tw + fr) * D + head * 256 + pp * 128 + 8 * fq;
            const bf16_t* kbase = skl + ((size_t)(head * 2 + pp) * 128 + fr) * 128 + 8 * fq;
#pragma unroll
            for (int ks = 0; ks < 4; ++ks) { const bf16x8 af0 = *(const bf16x8*)(qrow + 32 * ks), af1 = *(const bf16x8*)(qrow + (size_t)16 * D + 32 * ks);
#pragma unroll
                for (int kb = 0; kb < 8; ++kb) { const bf16x8 bf = *(const bf16x8*)(kbase + (size_t)(16 * kb) * 128 + 32 * ks); acc[0][kb] = MFMA16(af0, bf, acc[0][kb]); acc[1][kb] = MFMA16(af1, bf, acc[1][kb]); } }
#pragma unroll
            for (int g = 0; g < 2; ++g)
#pragma unroll
                for (int kb = 0; kb < 8; ++kb)
#pragma unroll
                    for (int rg = 0; rg < 4; ++rg) SCw[(16 * g + 4 * fq + rg) * PS_ROW + 16 * kb + fr] = acc[g][kb][rg];
            PS_WAVE_SYNC();
            { LAS float* sp = SCw + (lane >> 1) * PS_ROW + 64 * (lane & 1);
              float tv[16];
#pragma unroll
              for (int i = 0; i < 16; ++i) tv[i] = -INFINITY;
#pragma unroll 4
              for (int k = 0; k < 64; ++k) { const float v = __uint_as_float((__float_as_uint(sp[k]) & ~127u) | (unsigned)(64 * (lane & 1) + k)); PS_INSERT(tv, v); }
#pragma unroll
              for (int i = 0; i < 16; ++i) sp[i] = tv[i]; }
            PS_WAVE_SYNC();
            if (lane < 32) { const LAS float* sp = SCw + lane * PS_ROW; float tv[16], ob[16];
#pragma unroll
                for (int i = 0; i < 16; ++i) { tv[i] = sp[i]; ob[i] = sp[64 + i]; }
#pragma unroll
                for (int i = 0; i < 16; ++i) PS_INSERT(tv, ob[i]);
#pragma unroll
                for (int i = 0; i < 16; ++i) { if (pp == 0) alist[i] = tv[i]; else blist[i] = tv[i]; } }
            PS_WAVE_SYNC();
        }
        if (lane < 32) {
            LAS float* pa = SCw + lane * PS_ROW; LAS float* pb = pa + 64;
#pragma unroll
            for (int i = 0; i < 16; ++i) { pa[i] = alist[i]; pb[i] = blist[i]; }
            float tv[16];
#pragma unroll
            for (int i = 0; i < 16; ++i) tv[i] = -INFINITY;
#pragma unroll
            for (int i = 0; i < 16; ++i)
#pragma unroll
                for (int j = 0; j < 16; ++j) if ((i + 1) * (j + 1) <= 16) { const float cvv = __uint_as_float((__float_as_uint(alist[i] + blist[j]) & ~255u) | (unsigned)(i * 16 + j)); PS_INSERT(tv, cvv); }
            float bs[16]; int bidx[16];
#pragma unroll
            for (int k = 0; k < 16; ++k) { const unsigned code = __float_as_uint(tv[k]) & 255u; const int i1 = (int)(__float_as_uint(pa[code >> 4]) & 127u), i2 = (int)(__float_as_uint(pb[code & 15u]) & 127u);
                bidx[k] = i1 * 128 + i2; bs[k] = tv[k]; }
            float den = 0.f; const float bmax = bs[0];
#pragma unroll
            for (int k = 0; k < 16; ++k) { bs[k] = __expf(bs[k] - bmax); den += bs[k]; }
            const float inv = 1.f / den;
            const size_t ob = (size_t)(tw + lane) * 128 + head * 16;
#pragma unroll
            for (int k4 = 0; k4 < 4; ++k4) { *(int4*)(pidx + ob + 4 * k4) = make_int4(bidx[4 * k4], bidx[4 * k4 + 1], bidx[4 * k4 + 2], bidx[4 * k4 + 3]);
                *(f32x4*)(pgate + ob + 4 * k4) = (f32x4){bs[4 * k4] * inv, bs[4 * k4 + 1] * inv, bs[4 * k4 + 2] * inv, bs[4 * k4 + 3] * inv}; }
        }
        PS_WAVE_SYNC();
    }
}

#define PG_ISSUE(UB, VB, e) do { const int _id = __builtin_amdgcn_readlane(((e) < 64) ? idA : idB, (e) & 63); unsigned _lo = loff; asm("" : "+v"(_lo));   \
    const unsigned char* _u = U6 + (size_t)_id * PROW; const unsigned char* _v = V6 + (size_t)_id * PROW; \
    UB[0] = *(const u32x2*)(_u + _lo); UB[1] = *(const u32x2*)(_u + _lo + 8); UB[2] = *(const u32x2*)(_u + _lo + 16); VB[0] = *(const u32x2*)(_v + _lo); VB[1] = *(const u32x2*)(_v + _lo + 8); VB[2] = *(const u32x2*)(_v + _lo + 16); } while (0)
#define PG_LANEF(A, B, e) __int_as_float(__builtin_amdgcn_readlane(__float_as_int(((e) < 64) ? A : B), (e) & 63))
#define PG_DEC(B) __builtin_amdgcn_cvt_scalef32_pk32_f32_fp6((u32x6){B[0].x, B[0].y, B[1].x, B[1].y, B[2].x, B[2].y}, 1.0f)
#define PG_COMPUTE(UB, VB, e) do { float _d0 = 0.f, _d1 = 0.f; { const f32x32 _ud = PG_DEC(UB); \
    _Pragma("unroll") for (int _i = 0; _i < 32; _i += 2) { _d0 += xf[_i] * _ud[_i]; _d1 += xf[_i + 1] * _ud[_i + 1]; } } \
    const float _d = wave_sum_dpp(_d0 + _d1) * PG_LANEF(suA, suB, e); const float _a = gelu_tanh(_d) * PG_LANEF(gsA, gsB, e); \
    { const f32x32 _vd = PG_DEC(VB); _Pragma("unroll") for (int _i = 0; _i < 32; ++_i) o[_i] += _a * _vd[_i]; } } while (0)
DI void wave_sum_dpp2(float a, float b, float& ra, float& rb) {
    a += dpp_get<0xB1, 0xf>(a); b += dpp_get<0xB1, 0xf>(b); a += dpp_get<0x4E, 0xf>(a); b += dpp_get<0x4E, 0xf>(b);
    a += dpp_get<0x141, 0xf>(a); b += dpp_get<0x141, 0xf>(b); a += dpp_get<0x140, 0xf>(a); b += dpp_get<0x140, 0xf>(b);
    a += dpp_get<0x142, 0xa>(a); b += dpp_get<0x142, 0xa>(b); a += dpp_get<0x143, 0xc>(a); b += dpp_get<0x143, 0xc>(b);
    ra = __int_as_float(__builtin_amdgcn_readlane(__float_as_int(a), 63)); rb = __int_as_float(__builtin_amdgcn_readlane(__float_as_int(b), 63));
}
#define PG_DECH(B) __builtin_bit_cast(H16, __builtin_amdgcn_cvt_scalef32_pk32_f16_fp6((u32x6){B[0].x, B[0].y, B[1].x, B[1].y, B[2].x, B[2].y}, 1.0f))
#define PG_DECB(B) __builtin_bit_cast(u32x16, __builtin_amdgcn_cvt_scalef32_pk32_bf16_fp6((u32x6){B[0].x, B[0].y, B[1].x, B[1].y, B[2].x, B[2].y}, 1.0f))
#define PG_COMPUTE2(UA, VA, UB, VB, e) do { float _a0 = 0.f, _a1 = 0.f, _b0 = 0.f, _b1 = 0.f; { const u32x16 _ua = PG_DECB(UA); const u32x16 _ub = PG_DECB(UB); \
    _Pragma("unroll") for (int _i = 0; _i < 16; _i += 2) { asm("v_dot2c_f32_bf16 %0, %1, %2" : "+v"(_a0) : "v"(xp[_i]), "v"(_ua[_i])); asm("v_dot2c_f32_bf16 %0, %1, %2" : "+v"(_b0) : "v"(xp[_i]), "v"(_ub[_i])); \
        asm("v_dot2c_f32_bf16 %0, %1, %2" : "+v"(_a1) : "v"(xp[_i + 1]), "v"(_ua[_i + 1])); asm("v_dot2c_f32_bf16 %0, %1, %2" : "+v"(_b1) : "v"(xp[_i + 1]), "v"(_ub[_i + 1])); } } \
    float _da, _db; wave_sum_dpp2(_a0 + _a1, _b0 + _b1, _da, _db); _da *= PG_LANEF(suA, suB, e); _db *= PG_LANEF(suA, suB, (e) + 1); \
    const float _ga = gelu_tanh(_da) * PG_LANEF(gsA, gsB, e), _gb = gelu_tanh(_db) * PG_LANEF(gsA, gsB, (e) + 1); \
    { const H16 _vd = PG_DECH(VA); const _Float16 _h = (_Float16)(_ga * 256.f); const h2 _g2 = {_h, _h}; _Pragma("unroll") for (int _i = 0; _i < 16; ++_i) o2[_i] = _g2 * _vd.v[_i] + o2[_i]; } \
    { const H16 _vd = PG_DECH(VB); const _Float16 _h = (_Float16)(_gb * 256.f); const h2 _g2 = {_h, _h}; _Pragma("unroll") for (int _i = 0; _i < 16; ++_i) o2[_i] = _g2 * _vd.v[_i] + o2[_i]; } } while (0)
DI void peer_gather_phase(const Params& p, int l, bool last, LAS unsigned char* lds) {
    const int tid = threadIdx.x, lane = tid & 63, wave = __builtin_amdgcn_readfirstlane(tid >> 6); const unsigned loff = 24u * (unsigned)lane;
    const unsigned char* U6 = p.ws + WS_PU + (size_t)l * PEER_N * PROW;
    const unsigned char* V6 = p.ws + WS_PV + (size_t)l * PEER_N * PROW;
    const float* su = (const float*)(p.ws + WS_PSU) + l * PEER_N; const float* sv = (const float*)(p.ws + WS_PSV) + l * PEER_N;
    const int* pidx = (const int*)(p.ws + WS_PIDX); const float* pgate = (const float*)(p.ws + WS_PGATE);
    bf16_t* hbuf = (bf16_t*)(p.ws + WS_H);
    float* xres = p.out + OUT_YP;
    const float* mod = (const float*)(p.ws + WS_MOD);
    for (int tok = blockIdx.x * NWAVES + wave; tok < NTOK; tok += gridDim.x * NWAVES) {
        int ln = lane; asm volatile("" : "+v"(ln));
        unsigned xp[16];
#pragma unroll
        for (int q = 0; q < 4; ++q) { const u32x4 a = *(const u32x4*)(hbuf + (size_t)tok * D + 32 * ln + 8 * q); xp[4 * q] = a.x; xp[4 * q + 1] = a.y; xp[4 * q + 2] = a.z; xp[4 * q + 3] = a.w; }
        int idA = pidx[(size_t)tok * 128 + ln], idB = pidx[(size_t)tok * 128 + 64 + ln];
        float gA = pgate[(size_t)tok * 128 + ln], gB = pgate[(size_t)tok * 128 + 64 + ln];
        { int rA = 0, rB = 0;
          for (int j = 0; j < 64; ++j) { const int ja = __builtin_amdgcn_readlane(idA, j), jb = __builtin_amdgcn_readlane(idB, j);
              rA += (ja < idA || (ja == idA && j < lane)) ? 1 : 0; rA += (jb < idA) ? 1 : 0;
              rB += (ja <= idB) ? 1 : 0; rB += (jb < idB || (jb == idB && j < lane)) ? 1 : 0; }
          LAS int* sid = (LAS int*)(lds + wave * 1024); LAS float* sg = (LAS float*)(lds + wave * 1024 + 512);
          sid[rA] = idA; sg[rA] = gA; sid[rB] = idB; sg[rB] = gB;
          idA = sid[lane]; gA = sg[lane]; idB = sid[64 + lane]; gB = sg[64 + lane]; }
        const float suA = su[idA], suB = su[idB], gsA = gA * sv[idA], gsB = gB * sv[idB];
        h2 o2[16];
#pragma unroll
        for (int j = 0; j < 16; ++j) o2[j] = (h2){(_Float16)0.f, (_Float16)0.f};
        u32x2 u0[3], v0[3], u1[3], v1[3], u2[3], v2[3], u3[3], v3[3], u4[3], v4[3], u5[3], v5[3];
        PG_ISSUE(u0, v0, 0); PG_ISSUE(u1, v1, 1); PG_ISSUE(u2, v2, 2); PG_ISSUE(u3, v3, 3);
        for (int e = 0; e < 120; e += 6) {
            PG_ISSUE(u4, v4, e + 4); PG_ISSUE(u5, v5, e + 5); PG_COMPUTE2(u0, v0, u1, v1, e);
            PG_ISSUE(u0, v0, e + 6); PG_ISSUE(u1, v1, e + 7); PG_COMPUTE2(u2, v2, u3, v3, e + 2);
            PG_ISSUE(u2, v2, e + 8); PG_ISSUE(u3, v3, e + 9); PG_COMPUTE2(u4, v4, u5, v5, e + 4);
        }
        PG_ISSUE(u4, v4, 124); PG_ISSUE(u5, v5, 125); PG_COMPUTE2(u0, v0, u1, v1, 120);
        PG_ISSUE(u0, v0, 126); PG_ISSUE(u1, v1, 127); PG_COMPUTE2(u2, v2, u3, v3, 122);
        PG_COMPUTE2(u4, v4, u5, v5, 124);
        PG_COMPUTE2(u0, v0, u1, v1, 126);
        float o[32];
#pragma unroll
        for (int j = 0; j < 16; ++j) { o[2 * j] = (float)o2[j].x * (1.f / 256.f); o[2 * j + 1] = (float)o2[j].y * (1.f / 256.f); }
        const float* mc = mod + (size_t)(l * 9 + cond_of_row(tok)) * 12288;
        f32x4 xn[8]; float ss = 0.f;
#pragma unroll
        for (int q = 0; q < 8; ++q) { const int eo = 32 * ln + 4 * q; const f32x4 xv = *(const f32x4*)(xres + (size_t)tok * D + eo), gt = *(const f32x4*)(mc + 5 * D + eo);
#pragma unroll
            for (int j = 0; j < 4; ++j) { xn[q][j] = xv[j] + gt[j] * o[4 * q + j]; ss += xn[q][j] * xn[q][j]; } }
        ss = wave_sum(ss);
        const float rs = rsqrtf(ss * (1.f / 2048.f) + 1e-6f);
        if (!last) {
            const float* mn = mod + (size_t)((l + 1) * 9 + cond_of_row(tok)) * 12288; const float* g = p.norm1_g + (l + 1) * D;
            u32x4 w[4];
#pragma unroll
            for (int q2 = 0; q2 < 4; ++q2)
#pragma unroll
                for (int hq = 0; hq < 2; ++hq) { const int q = 2 * q2 + hq, eo = 32 * ln + 4 * q;
                    const f32x4 gv = *(const f32x4*)(g + eo), sh = *(const f32x4*)(mn + eo), sc = *(const f32x4*)(mn + D + eo); float y[4];
#pragma unroll
                    for (int j = 0; j < 4; ++j) y[j] = xn[q][j] * rs * gv[j] * (1.f + sc[j]) + sh[j];
                    w[q2][2 * hq] = cvt_pk_bf16(y[0], y[1]); w[q2][2 * hq + 1] = cvt_pk_bf16(y[2], y[3]); }
            asm volatile("" ::: "memory");
#pragma unroll
            for (int q = 0; q < 8; ++q) *(f32x4*)(xres + (size_t)tok * D + 32 * ln + 4 * q) = xn[q];
#pragma unroll
            for (int q2 = 0; q2 < 4; ++q2) *(u32x4*)(hbuf + (size_t)tok * D + 32 * ln + 8 * q2) = w[q2];
        } else {
            f32x4 y[8];
#pragma unroll
            for (int q = 0; q < 8; ++q) { const int eo = 32 * ln + 4 * q; const f32x4 gv = *(const f32x4*)(p.final_norm_g + eo);
#pragma unroll
                for (int j = 0; j < 4; ++j) y[q][j] = xn[q][j] * rs * gv[j]; }
            asm volatile("" ::: "memory");
#pragma unroll
            for (int q = 0; q < 8; ++q) *(f32x4*)(xres + (size_t)tok * D + 32 * ln + 4 * q) = y[q];
        }
    }
}

constexpr int N_PHASES = 16;
#ifndef MK_SPLIT
#define MK_SPLIT 0
#endif

__global__ void __launch_bounds__(NTHR, 2) mk_fwd(Params p) {
    extern __shared__ __attribute__((aligned(16))) unsigned char lds_raw[];
    LAS unsigned char* lds = (LAS unsigned char*)lds_raw;
    const int tid = threadIdx.x;
    volatile LAS unsigned* misc = (volatile LAS unsigned*)(lds + LDS_MISC);
    if (tid < 64) misc[tid] = 0u;
    __syncthreads();
    unsigned char* ws = p.ws;
    XcdBarrier bar; bar.bar = (unsigned*)(ws + WS_BAR); bar.x = 0; bar.st = nullptr;
    const bool fused = (p.ph_hi - p.ph_lo) > 1;
    if (fused) bar = xcd_barrier_post((unsigned*)(ws + WS_BAR), misc + 8);
#define PH(k) (p.ph_lo <= (k) && (k) < p.ph_hi)
#define SEAM(k) do { if (p.ph_lo <= (k) && (k) + 1 < p.ph_hi) xcd_barrier(bar); } while (0)
    float* mod = (float*)(ws + WS_MOD);
    bf16_t* hbuf = (bf16_t*)(ws + WS_H);
    bf16_t* proj = (bf16_t*)(ws + WS_PROJ);
    bf16_t* mix = (bf16_t*)(ws + WS_MIX);
    float* xres = p.out + OUT_YP;

    if (PH(0)) prologue_phase(p, lds);
    SEAM(0);
    if (PH(1)) norm_phase<true>(p, 0, 0);
    SEAM(1);
    if (PH(2)) {
        pg8::Gemm g; g.A = hbuf; g.Bt = (const bf16_t*)(ws + WS_WEI); g.M = NTOK; g.N = EVEN_IN; g.K = D;
        pg8::StaticOrder S; S.init(g.M, g.N, (int)gridDim.x, (int)blockIdx.x);
        EpiProj E; E.O = proj; E.ldc = EVEN_IN; E.outK = p.out + OUT_AK; E.outV = p.out + OUT_AV; E.kstart = 1024; E.vstart = 2048; E.kvw = 1024; E.rope = (const float*)(ws + WS_ROPE);
        pg8::gemm_phase<EpiProj, pg8::StaticOrder, false>(lds, g, S, E, nullptr);
    }
    SEAM(2);
    if (PH(3)) {
        unsigned* ctrL = (unsigned*)(ws + WS_CTR); unsigned* ctrA = ctrL + 64;
        for (;;) {
            const int u = q_next(ctrL, misc);
            if (u >= 320) break;
            const int seq = u < 64 ? 32 + (u >> 3) : ((u - 64) >> 3), blk = u & 7;
            lru_unit(p, lds, seq, blk);
        }
        const bf16_t* cak = (const bf16_t*)(ws + WS_CAK); const bf16_t* cav = (const bf16_t*)(ws + WS_CAV);
        const float lam = ((const float*)(ws + WS_SCAL))[0];
        for (;;) {
            const int u = q_next(ctrA, misc);
            if (u >= 2560) break;
            AttnArgs a; a.C = 0.125f * 1.4426950408889634f; a.lam = lam; a.subg = p.a_subln_g; a.rpb = nullptr; a.qr0 = 0; a.krlo = 0; a.ldq = EVEN_IN; a.ldo = D; a.ld1 = EVEN_IN;
            if (u < 2048) { const int b = u >> 8, head = (u & 255) >> 5, qb = u & 31; const size_t tb = NP + (size_t)b * TS;
                a.Q = proj + (tb + 128 * qb) * EVEN_IN + head * 128;
                a.K0 = cak + (size_t)b * PAST * 1024 + head * 128; a.V0 = cav + (size_t)b * PAST * 1024 + head * 128; a.n0 = PAST; a.ld0 = 1024;
                a.K1 = proj + tb * EVEN_IN + 1024 + head * 128; a.V1 = proj + tb * EVEN_IN + 2048 + head * 128; a.n1 = TS;
                a.O = mix + (tb + 128 * qb) * D + head * 128;
            } else { const int i = u - 2048, b = i >> 4, head = (i & 15) >> 1, half = i & 1; const size_t tb = (size_t)b * TP;
                a.Q = proj + (tb + 128 * half) * EVEN_IN + head * 128;
                a.K0 = proj + tb * EVEN_IN + 1024 + head * 128; a.V0 = proj + tb * EVEN_IN + 2048 + head * 128; a.n0 = TP; a.ld0 = EVEN_IN;
                a.K1 = a.K0; a.V1 = a.V0; a.n1 = 0;
                a.O = mix + (tb + 128 * half) * D + head * 128;
            }
            attn_unit<0>(lds, a);
        }
    }
    SEAM(3);
    if (PH(4)) {
        pg8::Gemm g; g.A = mix; g.Bt = (const bf16_t*)(ws + WS_WEO); g.M = NTOK; g.N = D; g.K = D;
        pg8::StaticOrder S; S.init(g.M, g.N, (int)gridDim.x, (int)blockIdx.x);
        EpiResid E; E.xin_p = p.x_prompt; E.xin_s = p.x_sample; E.xout = xres; E.gate = mod + 2 * D;
        pg8::gemm_phase<EpiResid, pg8::StaticOrder, false>(lds, g, S, E, nullptr);
    }
    SEAM(4);
    if (PH(5)) norm_phase<false>(p, 0, 1);
    SEAM(5);
    if (PH(6)) {
        pg8::Gemm g; g.A = hbuf; g.Bt = (const bf16_t*)(ws + WS_WPQ); g.M = NTOK; g.N = D; g.K = D;
        pg8::StaticOrder S; S.init(g.M, g.N, (int)gridDim.x, (int)blockIdx.x);
        EpiBf E; E.O = mix; E.ldc = D;
        pg8::gemm_phase<EpiBf, pg8::StaticOrder, false>(lds, g, S, E, nullptr);
    }
    SEAM(6);
    if (PH(7)) peer_select_phase(p, 0, lds);
    SEAM(7);
    if (PH(8)) peer_gather_phase(p, 0, false, lds);
    SEAM(8);
    if (PH(9)) {
        pg8::Gemm g; g.A = hbuf; g.Bt = (const bf16_t*)(ws + WS_WOI); g.M = NTOK; g.N = ODD_IN; g.K = D;
        pg8::StaticOrder S; S.init(g.M, g.N, (int)gridDim.x, (int)blockIdx.x);
        EpiProj E; E.O = proj; E.ldc = ODD_IN; E.outK = p.out + OUT_CK; E.outV = p.out + OUT_CV; E.kstart = 2048; E.vstart = 4096; E.kvw = 2048; E.rope = nullptr;
        pg8::gemm_phase<EpiProj, pg8::StaticOrder, false>(lds, g, S, E, nullptr);
    }
    SEAM(9);
    if (PH(10)) {
        unsigned* ctrN = (unsigned*)(ws + WS_CTR) + 128; unsigned* ctrD = ctrN + 64;
        const bf16_t* cck = (const bf16_t*)(ws + WS_CCK); const bf16_t* ccv = (const bf16_t*)(ws + WS_CCV);
        for (;;) {
            const int u = q_next(ctrN, misc);
            if (u >= 2048) break;
            AttnArgs a; a.C = 0.08838834764831845f * 1.4426950408889634f; a.lam = 0.f; a.subg = nullptr; a.ldq = ODD_IN; a.ldo = D;
            const int b = u >> 8, head = (u & 255) >> 4, rb = u & 15; const size_t tb = NP + (size_t)b * TS;
            const int krlo = min(max(4 * rb - 4, 0), 56), krhi = min(max(4 * rb - 1, 0), 56) + 7;
            a.Q = proj + (tb + 256 * rb) * ODD_IN + head * 128;
            a.K0 = cck + (size_t)b * PAST * 2048 + head * 128; a.V0 = ccv + (size_t)b * PAST * 2048 + head * 128; a.n0 = PAST; a.ld0 = 2048;
            a.K1 = proj + (tb + 64 * krlo) * ODD_IN + 2048 + head * 128; a.V1 = proj + (tb + 64 * krlo) * ODD_IN + 4096 + head * 128; a.n1 = (krhi - krlo + 1) * 64; a.ld1 = ODD_IN;
            a.O = mix + (tb + 256 * rb) * D + head * 128; a.rpb = p.na_rpb + head * 465; a.qr0 = 4 * rb; a.krlo = krlo;
            attn_unit<2>(lds, a);
        }
        for (;;) {
            const int u = q_next(ctrD, misc);
            if (u >= 512) break;
            AttnArgs a; a.C = 0.08838834764831845f * 1.4426950408889634f; a.lam = 0.f; a.subg = nullptr; a.ldq = ODD_IN; a.ldo = D;
            const int b = u >> 4, head = u & 15; const size_t tb = (size_t)b * TP;
            a.Q = proj + tb * ODD_IN + head * 128;
            a.K0 = proj + tb * ODD_IN + 2048 + head * 128; a.V0 = proj + tb * ODD_IN + 4096 + head * 128; a.n0 = TP; a.ld0 = ODD_IN;
            a.K1 = a.K0; a.V1 = a.V0; a.n1 = 0; a.ld1 = ODD_IN;
            a.O = mix + tb * D + head * 128; a.rpb = nullptr; a.qr0 = 0; a.krlo = 0;
            attn_unit<1>(lds, a);
        }
    }
    SEAM(10);
    if (PH(11)) {
        pg8::Gemm g; g.A = mix; g.Bt = (const bf16_t*)(ws + WS_WOO); g.M = NTOK; g.N = D; g.K = D;
        pg8::StaticOrder S; S.init(g.M, g.N, (int)gridDim.x, (int)blockIdx.x);
        EpiResid E; E.xin_p = xres; E.xin_s = xres + (size_t)NP * D; E.xout = xres; E.gate = mod + (size_t)9 * 12288 + 2 * D;
        pg8::gemm_phase<EpiResid, pg8::StaticOrder, false>(lds, g, S, E, nullptr);
    }
    SEAM(11);
    if (PH(12)) norm_phase<false>(p, 1, 1);
    SEAM(12);
    if (PH(13)) {
        pg8::Gemm g; g.A = hbuf; g.Bt = (const bf16_t*)(ws + WS_WPQ) + (size_t)D * D; g.M = NTOK; g.N = D; g.K = D;
        pg8::StaticOrder S; S.init(g.M, g.N, (int)gridDim.x, (int)blockIdx.x);
        EpiBf E; E.O = mix; E.ldc = D;
        pg8::gemm_phase<EpiBf, pg8::StaticOrder, false>(lds, g, S, E, nullptr);
    }
    SEAM(13);
    if (PH(14)) peer_select_phase(p, 1, lds);
    SEAM(14);
    if (PH(15)) peer_gather_phase(p, 1, true, lds);

#undef PH
#undef SEAM
}

extern "C" void kernel_launch(void* const* d_in, const int* in_sizes, int n_in, void* d_out, int out_size, void* d_ws, size_t ws_size, hipStream_t stream) {
    static int grid = 0;
    if (grid == 0) {
        if (n_in != 32 || ws_size < WS_END || (size_t)out_size != OUT_END) { fprintf(stderr, "kernel_launch: unexpected shapes: n_in %d out %d ws %zu (need %zu)\n", n_in, out_size, ws_size, (size_t)WS_END); grid = -1; return; }
        int dev = 0, cus = 0, per_cu = 0;
        if (hipGetDevice(&dev) != hipSuccess || hipDeviceGetAttribute(&cus, hipDeviceAttributeMultiprocessorCount, dev) != hipSuccess) { grid = -1; return; }
        if (hipFuncSetAttribute((const void*)mk_fwd, hipFuncAttributeMaxDynamicSharedMemorySize, LDS_BYTES) != hipSuccess) { fprintf(stderr, "kernel_launch: hipFuncSetAttribute failed\n"); grid = -1; return; }
        if (hipOccupancyMaxActiveBlocksPerMultiprocessor(&per_cu, (const void*)mk_fwd, NTHR, LDS_BYTES) != hipSuccess || per_cu < 1) { fprintf(stderr, "kernel_launch: occupancy query says %d\n", per_cu); }
        (void)hipGetLastError();
        grid = cus;
    }
    if (grid < 0) return;
    (void)hipMemsetAsync((char*)d_ws + WS_BAR, 0, WS_ZERO_BYTES, stream);
    Params p{};
    const float** pp = (const float**)&p;
    for (int i = 0; i < 32; ++i) pp[i] = (const float*)d_in[i];
    p.out = (float*)d_out; p.ws = (unsigned char*)d_ws;
#if MK_SPLIT
    for (int k = 0; k < N_PHASES; ++k) { p.ph_lo = k; p.ph_hi = k + 1; hipLaunchKernelGGL(mk_fwd, dim3(grid), dim3(NTHR), LDS_BYTES, stream, p); }
#else
    p.ph_lo = 0; p.ph_hi = N_PHASES;
    hipLaunchKernelGGL(mk_fwd, dim3(grid), dim3(NTHR), LDS_BYTES, stream, p);
#endif
    const hipError_t le = hipPeekAtLastError();
    if (le != hipSuccess) fprintf(stderr, "kernel_launch: launch failed: %s\n", hipGetErrorName(le));
}
```

```cpp
#include <hip/hip_runtime.h>
#include <stdint.h>
#include <stdio.h>

#define LAS __attribute__((address_space(3)))
typedef unsigned short bf16_t;
typedef short bf16x8 __attribute__((ext_vector_type(8)));
typedef short s16x4 __attribute__((ext_vector_type(4)));
typedef float f32x2 __attribute__((ext_vector_type(2)));
typedef float f32x4 __attribute__((ext_vector_type(4)));
typedef float f32x16 __attribute__((ext_vector_type(16)));
typedef unsigned u32x2 __attribute__((ext_vector_type(2)));
typedef unsigned u32x4 __attribute__((ext_vector_type(4)));
typedef unsigned u32x6 __attribute__((ext_vector_type(6)));
typedef unsigned u32x16 __attribute__((ext_vector_type(16)));
typedef float f32x32 __attribute__((ext_vector_type(32)));
typedef _Float16 h2 __attribute__((ext_vector_type(2)));
struct H16 { h2 v[16]; };
#define DI __device__ __forceinline__

constexpr int D = 2048, NP = 8192  , NS = 32768  , NTOK = NP + NS;
constexpr int TP = 256, TS = 4096, PAST = 512;
constexpr int EVEN_IN = 5120, ODD_IN = 6144;
constexpr int PEER_N = 16384;
constexpr int NWAVES = 8, NTHR = 512;
constexpr int LDS_BYTES = 147456;
constexpr int LDS_MISC = LDS_BYTES - 256;

constexpr size_t OUT_YP = 0, OUT_YS = OUT_YP + (size_t)NP * D, OUT_AK = OUT_YS + (size_t)NS * D, OUT_AV = OUT_AK + (size_t)NP * 1024,
                 OUT_LRU = OUT_AV + (size_t)NP * 1024, OUT_CK = OUT_LRU + 32 * 2 * 1024, OUT_CV = OUT_CK + (size_t)NP * 2048, OUT_END = OUT_CV + (size_t)NP * 2048;

constexpr size_t al256(size_t x) { return (x + 255) & ~(size_t)255; }
constexpr size_t WS_BAR = 0;
constexpr size_t WS_CTR = 16384;
constexpr size_t WS_ZERO_BYTES = 20480;
constexpr size_t WS_SCAL = WS_ZERO_BYTES;
constexpr size_t WS_ROPE = WS_SCAL + 256;
constexpr size_t WS_MOD = al256(WS_ROPE + 64 * 16 * 2 * 4);
constexpr size_t WS_WEI = al256(WS_MOD + (size_t)2 * 9 * 12288 * 4);
constexpr size_t WS_WEO = WS_WEI + (size_t)EVEN_IN * D * 2;
constexpr size_t WS_WOI = WS_WEO + (size_t)D * D * 2;
constexpr size_t WS_WOO = WS_WOI + (size_t)ODD_IN * D * 2;
constexpr size_t WS_WPQ = WS_WOO + (size_t)D * D * 2;
constexpr size_t WS_SK = WS_WPQ + (size_t)2 * D * D * 2;
constexpr size_t WS_LRW = WS_SK + (size_t)2 * 8 * 2 * 128 * 128 * 2;
constexpr size_t WS_CAK = WS_LRW + (size_t)2 * 2 * 8 * 128 * 128 * 2;
constexpr size_t WS_CAV = WS_CAK + (size_t)8 * 512 * 1024 * 2;
constexpr size_t WS_CCK = WS_CAV + (size_t)8 * 512 * 1024 * 2;
constexpr size_t WS_CCV = WS_CCK + (size_t)8 * 512 * 2048 * 2;
constexpr int PROW = 1536;
constexpr size_t WS_PU = WS_CCV + (size_t)8 * 512 * 2048 * 2;
constexpr size_t WS_PV = WS_PU + (size_t)2 * PEER_N * PROW;
constexpr size_t WS_PSU = WS_PV + (size_t)2 * PEER_N * PROW;
constexpr size_t WS_PSV = WS_PSU + (size_t)2 * PEER_N * 4;
constexpr size_t WS_H = WS_PSV + (size_t)2 * PEER_N * 4;
constexpr size_t WS_PROJ = WS_H + (size_t)NTOK * D * 2;
constexpr size_t WS_MIX = WS_PROJ + (size_t)NTOK * ODD_IN * 2;
constexpr size_t WS_PIDX = WS_MIX + (size_t)NTOK * D * 2;
constexpr size_t WS_PGATE = WS_PIDX + (size_t)NTOK * 128 * 4;
constexpr size_t WS_END = WS_PGATE + (size_t)NTOK * 128 * 4;

struct Params {
    const float *x_prompt, *x_sample, *cache_a_k, *cache_a_v, *state_lru, *cache_c_k, *cache_c_v, *c, *c_ctx, *w_mod, *b_mod, *norm1_g, *norm2_g, *final_norm_g,
        *even_w_in, *even_w_out, *a_lambda, *a_subln_g, *lru_conv_w, *lru_conv_b, *lru_w_a, *lru_b_a, *lru_w_i, *lru_b_i, *lru_lambda,
        *odd_w_in, *odd_w_out, *na_rpb, *peer_w_q, *peer_sub_keys, *peer_u, *peer_v;
    float* out; unsigned char* ws; int ph_lo, ph_hi;
};

DI unsigned cvt_pk_bf16(float lo, float hi) { unsigned r; asm volatile("v_cvt_pk_bf16_f32 %0, %1, %2" : "=v"(r) : "v"(lo), "v"(hi)); return r; }
DI float bf_lo(unsigned u) { return __uint_as_float(u << 16); }
DI float bf_hi(unsigned u) { return __uint_as_float(u & 0xffff0000u); }
DI float wave_sum(float v) { v += __shfl_xor(v, 1); v += __shfl_xor(v, 2); v += __shfl_xor(v, 4); v += __shfl_xor(v, 8); v += __shfl_xor(v, 16); v += __shfl_xor(v, 32); return v; }
template <int CTRL, int ROWMASK> DI float dpp_get(float v) { return __int_as_float(__builtin_amdgcn_update_dpp(0, __float_as_int(v), CTRL, ROWMASK, 0xf, false)); }
DI float wave_sum_dpp(float v) {
    v += dpp_get<0xB1, 0xf>(v); v += dpp_get<0x4E, 0xf>(v); v += dpp_get<0x141, 0xf>(v); v += dpp_get<0x140, 0xf>(v);
    v += dpp_get<0x142, 0xa>(v); v += dpp_get<0x143, 0xc>(v);
    return __int_as_float(__builtin_amdgcn_readlane(__float_as_int(v), 63));
}
DI int cond_of_row(int row) { return row < NP ? 0 : 1 + ((row - NP) >> 12); }
DI float gelu_tanh(float x) { const float u2 = (2.f * 0.7978845608028654f * 1.4426950408889634f) * (x + 0.044715f * x * x * x); return x * __builtin_amdgcn_rcpf(1.f + __builtin_amdgcn_exp2f(-u2)); }

#define XB_TMO      128
#define XB_XCNT(j)  (256  + 64 * (j))
#define XB_XSUB(j)  (1280 + 64 * (j))
#define XB_XGEN(j)  (2304 + 64 * (j))
#define XB_TOP      3328
#define XB_TOPGEN   3392
#define XCD_BAR_WORDS 3456
#define XB_SPIN_CAP (1u << 18)

__device__ __forceinline__ unsigned xb_ld(unsigned* p)              { return __hip_atomic_load(p, __ATOMIC_RELAXED, __HIP_MEMORY_SCOPE_AGENT); }
__device__ __forceinline__ unsigned xb_add(unsigned* p, unsigned v) { return __hip_atomic_fetch_add(p, v, __ATOMIC_RELAXED, __HIP_MEMORY_SCOPE_AGENT); }
__device__ __forceinline__ unsigned xb_xcc_id() { return (unsigned)__builtin_amdgcn_s_getreg((3 << 11) | 20) & 0xFu; }
#define XB_SPIN(cond, bar) do { unsigned _sp = 0; while (cond) { __builtin_amdgcn_s_sleep(1); \
    if ((++_sp & 255u) == 0u) { if (xb_ld(&(bar)[XB_TMO])) break; if (_sp > XB_SPIN_CAP) { atomicAdd(&(bar)[XB_TMO], 1u); break; } } } } while (0)

struct XcdBarrier {
    unsigned* bar; unsigned x;
    volatile LAS unsigned* st;
};

__device__ __forceinline__ XcdBarrier xcd_barrier_post(unsigned* bar, volatile LAS unsigned* st) {
    XcdBarrier b; b.bar = bar; b.x = xb_xcc_id(); b.st = st;
    if (threadIdx.x == 0) (void)xb_add(&bar[XB_XCNT(b.x)], 1u);
    return b;
}
__device__ __forceinline__ void xcd_barrier_complete(unsigned* bar, unsigned x, unsigned& nloc, unsigned& nx) {
    const unsigned G = gridDim.x * gridDim.y * gridDim.z;
    unsigned sum, cnt, mine, sp = 0u;
    for (;;) {
        sum = 0u; cnt = 0u; mine = 0u;
#pragma unroll
        for (unsigned j = 0; j < 16; ++j) { const unsigned c = xb_ld(&bar[XB_XCNT(j)]); sum += c; cnt += (c > 0u) ? 1u : 0u; mine = (j == x) ? c : mine; }
        if (sum == G) break;
        __builtin_amdgcn_s_sleep(1);
        if ((++sp & 255u) == 0u) { if (xb_ld(&bar[XB_TMO])) break; if (sp > XB_SPIN_CAP) { atomicAdd(&bar[XB_TMO], 1u); break; } }
    }
    nloc = mine > 0u ? mine : 1u; nx = cnt > 0u ? cnt : 1u;
}

__device__ __forceinline__ void xcd_barrier(const XcdBarrier& b) {
    asm volatile("s_waitcnt vmcnt(0)" ::: "memory");
    __syncthreads();
    if (threadIdx.x == 0) {
        unsigned* bar = b.bar;
        __builtin_amdgcn_s_waitcnt(0);
        unsigned nloc = b.st[0], nx = b.st[1];
        if (nloc == 0u) { xcd_barrier_complete(bar, b.x, nloc, nx); b.st[0] = nloc; b.st[1] = nx; }
        const unsigned old = xb_add(&bar[XB_XSUB(b.x)], 1u);
        const unsigned gen = old / nloc;
        if (old + 1u == (gen + 1u) * nloc) {
            __builtin_amdgcn_fence(__ATOMIC_RELEASE, "agent");
            asm volatile("s_waitcnt vmcnt(0)" ::: "memory");
            const unsigned og = xb_add(&bar[XB_TOP], 1u);
            const unsigned tg = og / nx;
            if (og + 1u == (tg + 1u) * nx) xb_add(&bar[XB_TOPGEN], 1u);
            else XB_SPIN(xb_ld(&bar[XB_TOPGEN]) == tg, bar);
            __builtin_amdgcn_fence(__ATOMIC_ACQUIRE, "agent");
            xb_add(&bar[XB_XGEN(b.x)], 1u);
            asm volatile("s_waitcnt vmcnt(0)" ::: "memory");
        } else {
            XB_SPIN(xb_ld(&bar[XB_XGEN(b.x)]) == gen, bar);
            __builtin_amdgcn_fence(__ATOMIC_ACQUIRE, "agent");
            asm volatile("s_waitcnt vmcnt(0)" ::: "memory");
        }
    }
    __syncthreads();
}

namespace pg8 {
#define PG8_LAS __attribute__((address_space(3)))
typedef unsigned short bf16_t;
typedef short bf16x8 __attribute__((ext_vector_type(8)));
typedef float f32x4 __attribute__((ext_vector_type(4)));
typedef unsigned u32x4 __attribute__((ext_vector_type(4)));
constexpr int BM = 256, BK = 64, HALF = 128, HTB = HALF * BK * 2  , STAGE_BYTES = 8 * HTB, NXCD = 8, WGM = 8;

__host__ __device__ __forceinline__ int lds_byte(int r, int c) { const int st = (r >> 4) * 2 + (c >> 5), rr = r & 15, cc = c & 31, ob = rr * 64 + cc * 2; return st * 1024 + (ob ^ (((ob >> 9) & 1) << 5)); }
__host__ __device__ __forceinline__ void stage_rc(int b, int& R, int& C) { const int st = b / 1024, sb = b % 1024, swz = sb ^ (((sb >> 9) & 1) << 5); R = (st >> 1) * 16 + swz / 64; C = (st & 1) * 32 + (swz % 64) / 2; }
__host__ __device__ __forceinline__ int perm32(int rho) { const int n = rho >> 4, i = rho & 15; return 8 * (i >> 2) + 4 * n + (i & 3); }

struct Unit { int pm, pn; };
struct Gemm { const bf16_t* A; const bf16_t* Bt; int M, N, K; };

struct StaticOrder {
    int nM, nN, nwg, G, c;
    __host__ __device__ void init(int M, int N, int G_, int c_) { nM = M / BM; nN = N / BM; nwg = nM * nN; G = G_; c = c_; }
    __host__ __device__ bool next(int i, Unit& u) const {
        const long L = (long)i * G + c; if (L >= nwg) return false;
        int wgid = (int)L; { const int q = nwg / NXCD, r = nwg % NXCD, xcd = wgid % NXCD, off = wgid / NXCD; wgid = (xcd < r ? xcd * (q + 1) : r * (q + 1) + (xcd - r) * q) + off; }
        const int nig = WGM * nN, gid = wgid / nig, fm = gid * WGM, gsz = (nM - fm) < WGM ? (nM - fm) : WGM;
        u.pm = fm + ((wgid % nig) % gsz); u.pn = (wgid % nig) / gsz; return true;
    }
    __device__ __forceinline__ void a_ready(const Unit&) const {}
    __device__ __forceinline__ void done(const Unit&) const {}
};

template <class Epi, class Sched, bool STAMP = false>
__device__ __forceinline__ void gemm_phase(PG8_LAS unsigned char* lds, const Gemm g, const Sched& S, const Epi& E, unsigned long long* stamps) {
    const int tid = threadIdx.x, wid = __builtin_amdgcn_readfirstlane(tid >> 6), lane = tid & 63, wr = wid >> 2, wc = wid & 3, fr = lane & 15, fq = lane >> 4;
    const int K = g.K, nt = K / BK;
    int ts_lo = 0, ts_hi = 0, nts = 0; const unsigned long long rt_entry = STAMP ? (unsigned long long)wall_clock64() : 0ull;
#define PG8_STAMP() do { if (STAMP && wid == 0 && nts < 64) { const unsigned long long _c = (unsigned long long)clock64(); \
        ts_lo = (lane == nts) ? (int)(unsigned)_c : ts_lo; ts_hi = (lane == nts) ? (int)(unsigned)(_c >> 32) : ts_hi; ++nts; } } while (0)
    PG8_STAMP();
    unsigned voffA[2], voffB[2];
#pragma unroll
    for (int i = 0; i < 2; ++i) { int R, C; stage_rc(tid * 16 + i * 8192, R, C); const int Rb = Epi::PERM ? ((R & ~31) + perm32(R & 31)) : R;
        voffA[i] = (unsigned)(R * K + C) * 2u; voffB[i] = (unsigned)(Rb * K + C) * 2u; }
    const size_t kstep = (size_t)(BK * 2);
    const size_t hstep = (size_t)HALF * K * 2;
    const size_t tstep = 2 * hstep;
    const unsigned ldsw = (unsigned)wid * 1024u;
    const int aoff = lds_byte(wr * 64 + fr, fq * 8), boff = lds_byte(wc * 32 + fr, fq * 8);
#define PG8_SA(b, h) (((b) * 2 + (h)) * HTB)
#define PG8_SB(b, h) ((4 + (b) * 2 + (h)) * HTB)
#define PG8_STAGE(bufoff, gbase, voff) do { _Pragma("unroll") for (int _i = 0; _i < 2; ++_i) \
        __builtin_amdgcn_global_load_lds((const unsigned*)((const char*)(gbase) + (voff)[_i]), (PG8_LAS unsigned*)(lds + (bufoff) + ldsw + _i * 8192), 16, 0, 0); } while (0)
#define PG8_LDA(dst, b, h) do { _Pragma("unroll") for (int m = 0; m < 4; ++m) _Pragma("unroll") for (int k = 0; k < 2; ++k) dst[m][k] = *(const PG8_LAS bf16x8*)(lds + PG8_SA(b, h) + aoff + m * 2048 + k * 1024); } while (0)
#define PG8_LDB(dst, b, h) do { _Pragma("unroll") for (int n = 0; n < 2; ++n) _Pragma("unroll") for (int k = 0; k < 2; ++k) dst[n][k] = *(const PG8_LAS bf16x8*)(lds + PG8_SB(b, h) + boff + n * 2048 + k * 1024); } while (0)
#define PG8_MMA(ai, bj, At, Bt) do { __builtin_amdgcn_s_setprio(1); _Pragma("unroll") for (int m = 0; m < 4; ++m) _Pragma("unroll") for (int n = 0; n < 2; ++n) _Pragma("unroll") for (int k = 0; k < 2; ++k) \
        acc[ai][bj][m][n] = __builtin_amdgcn_mfma_f32_16x16x32_bf16(Bt[n][k], At[m][k], acc[ai][bj][m][n], 0, 0, 0); __builtin_amdgcn_s_setprio(0); } while (0)
#define PG8_WAIT_V(n) asm volatile("s_waitcnt vmcnt(" #n ")" ::: "memory")
#define PG8_WAIT_L(n) asm volatile("s_waitcnt lgkmcnt(" #n ")" ::: "memory")
#define PG8_BAR __builtin_amdgcn_s_barrier()
#define PG8_SCHED __builtin_amdgcn_sched_barrier(0)
    Unit cur, nxt; int ui = 0;
    if (!S.next(0, cur)) return;
    f32x4 acc[2][2][4][2];
#pragma unroll
    for (int a = 0; a < 2; ++a)
#pragma unroll
        for (int b = 0; b < 2; ++b)
#pragma unroll
            for (int m = 0; m < 4; ++m)
#pragma unroll
                for (int n = 0; n < 2; ++n) acc[a][b][m][n] = (f32x4){0.f, 0.f, 0.f, 0.f};
    bf16x8 At[4][2], B0[2][2], B1[2][2];
    const char* cA = (const char*)g.A + (size_t)cur.pm * tstep; const char* cB = (const char*)g.Bt + (size_t)cur.pn * tstep;
    S.a_ready(cur);
    PG8_STAGE(PG8_SB(0, 0), cB, voffB); PG8_STAGE(PG8_SA(0, 0), cA, voffA); PG8_STAGE(PG8_SB(0, 1), cB + hstep, voffB); PG8_STAGE(PG8_SA(0, 1), cA + hstep, voffA);
    if (wr == 1) PG8_BAR;
    PG8_WAIT_V(4); PG8_BAR;
    PG8_STAGE(PG8_SB(1, 0), cB + kstep, voffB); PG8_STAGE(PG8_SA(1, 0), cA + kstep, voffA); PG8_STAGE(PG8_SB(1, 1), cB + hstep + kstep, voffB);
    PG8_WAIT_V(6); PG8_BAR;
    PG8_STAMP();
    for (;;) {
        const bool has_next = S.next(ui + 1, nxt);
        const char* nA = has_next ? (const char*)g.A + (size_t)nxt.pm * tstep : cA; const char* nB = has_next ? (const char*)g.Bt + (size_t)nxt.pn * tstep : cB;
        for (int t = 0; t < nt; t += 2) {
            const bool last = (t == nt - 2);
            const char* a1 = cA + (size_t)(t + 1) * kstep;
            const char* a2 = last ? nA : cA + (size_t)(t + 2) * kstep; const char* b2 = last ? nB : cB + (size_t)(t + 2) * kstep;
            const char* a3 = a2 + kstep; const char* b3 = b2 + kstep;
            if (last && has_next) S.a_ready(nxt);
            PG8_LDB(B0, 0, 0); PG8_SCHED; PG8_LDA(At, 0, 0); PG8_STAGE(PG8_SA(1, 1), a1 + hstep, voffA);
            PG8_WAIT_L(8); PG8_BAR; PG8_WAIT_L(0); PG8_MMA(0, 0, At, B0); PG8_BAR; PG8_SCHED;
            PG8_LDB(B1, 0, 1); PG8_STAGE(PG8_SB(0, 0), b2, voffB);
            PG8_BAR; PG8_WAIT_L(0); PG8_MMA(0, 1, At, B1); PG8_BAR;
            PG8_LDA(At, 0, 1); PG8_STAGE(PG8_SA(0, 0), a2, voffA);
            PG8_BAR; PG8_WAIT_L(0); PG8_MMA(1, 0, At, B0); PG8_BAR; PG8_SCHED;
            PG8_STAGE(PG8_SB(0, 1), b2 + hstep, voffB);
            PG8_WAIT_V(6); PG8_BAR; PG8_MMA(1, 1, At, B1); PG8_BAR;
            PG8_LDB(B0, 1, 0); PG8_SCHED; PG8_LDA(At, 1, 0); PG8_STAGE(PG8_SA(0, 1), a2 + hstep, voffA);
            PG8_WAIT_L(8); PG8_BAR; PG8_WAIT_L(0); PG8_MMA(0, 0, At, B0); PG8_BAR; PG8_SCHED;
            PG8_LDB(B1, 1, 1); PG8_STAGE(PG8_SB(1, 0), b3, voffB);
            PG8_BAR; PG8_WAIT_L(0); PG8_MMA(0, 1, At, B1); PG8_BAR;
            PG8_LDA(At, 1, 1); PG8_STAGE(PG8_SA(1, 0), a3, voffA);
            PG8_BAR; PG8_WAIT_L(0); PG8_MMA(1, 0, At, B0); PG8_BAR; PG8_SCHED;
            PG8_STAGE(PG8_SB(1, 1), b3 + hstep, voffB);
            PG8_WAIT_V(6); PG8_BAR; PG8_MMA(1, 1, At, B1); PG8_BAR;
        }
        PG8_STAMP();
        if constexpr (!Epi::AFTER_DRAIN) { E(acc, cur, wr, wc, fr, fq); S.done(cur); }
        PG8_STAMP();
        if (!has_next) break;
#pragma unroll
        for (int a = 0; a < 2; ++a)
#pragma unroll
            for (int b = 0; b < 2; ++b)
#pragma unroll
                for (int m = 0; m < 4; ++m)
#pragma unroll
                    for (int n = 0; n < 2; ++n) acc[a][b][m][n] = (f32x4){0.f, 0.f, 0.f, 0.f};
        cur = nxt; cA = nA; cB = nB; ++ui;
    }
    PG8_WAIT_V(0);
    if (wr == 0) PG8_BAR;
    PG8_BAR;
    if constexpr (Epi::AFTER_DRAIN) { E.fused(acc, cur, wr, wc, fr, fq, lds, wid, lane); S.done(cur); }
    PG8_STAMP();
    if (STAMP && wid == 0) { stamps[lane] = lane < nts ? (((unsigned long long)(unsigned)ts_hi << 32) | (unsigned)ts_lo) : 0ull;
        if (lane == 62) stamps[62] = rt_entry; if (lane == 63) stamps[63] = (unsigned long long)wall_clock64(); }
#undef PG8_STAMP
#undef PG8_SA
#undef PG8_SB
#undef PG8_STAGE
#undef PG8_LDA
#undef PG8_LDB
#undef PG8_MMA
#undef PG8_WAIT_V
#undef PG8_WAIT_L
#undef PG8_BAR
#undef PG8_SCHED
}
}

struct EpiProj {
    static constexpr bool PERM = true, AFTER_DRAIN = false;
    bf16_t* O; int ldc; float* outK; float* outV; int kstart, vstart, kvw; const float* rope;
    __device__ __forceinline__ void operator()(const f32x4 (&acc)[2][2][4][2], const pg8::Unit& u, int wr, int wc, int fr, int fq) const {
        const int row0 = u.pm * 256 + wr * 64 + fr, colt = u.pn * 256, col0 = colt + wc * 32 + 8 * fq;
        const bool prompt = u.pm < (NP / 256);
        const bool do_rope = (rope != nullptr) && !prompt && colt < 2048;
        float* side = nullptr; int scol = 0;
        if (prompt) { if (colt >= kstart && colt < kstart + kvw) { side = outK; scol = col0 - kstart; } else if (colt >= vstart && colt < vstart + kvw) { side = outV; scol = col0 - vstart; } }
        const float sgn = fq < 2 ? -1.f : 1.f; const int fbase = (8 * fq) & 15;
#pragma unroll
        for (int ai = 0; ai < 2; ++ai)
#pragma unroll
            for (int m = 0; m < 4; ++m) {
                const int row = row0 + ai * 128 + m * 16;
                f32x4 cs0 = {1.f, 0.f, 1.f, 0.f}, cs1 = cs0, cs2 = cs0, cs3 = cs0;
                if (do_rope) { const int t = (row - NP) & (TS - 1); const int pos = (wc & 1) ? (t & 63) : (t >> 6); const f32x4* rp = (const f32x4*)(rope + (pos * 16 + fbase) * 2);
                    cs0 = rp[0]; cs1 = rp[1]; cs2 = rp[2]; cs3 = rp[3]; }
                bf16_t* rowp = O + (size_t)row * ldc + col0;
#pragma unroll
                for (int bj = 0; bj < 2; ++bj) {
                    f32x4 v0 = acc[ai][bj][m][0], v1 = acc[ai][bj][m][1];
                    if (do_rope) {
                        f32x4 p0, p1;
#pragma unroll
                        for (int j = 0; j < 4; ++j) { p0[j] = __shfl_xor(v0[j], 32); p1[j] = __shfl_xor(v1[j], 32); }
                        v0[0] = v0[0] * cs0[0] + sgn * p0[0] * cs0[1]; v0[1] = v0[1] * cs0[2] + sgn * p0[1] * cs0[3];
                        v0[2] = v0[2] * cs1[0] + sgn * p0[2] * cs1[1]; v0[3] = v0[3] * cs1[2] + sgn * p0[3] * cs1[3];
                        v1[0] = v1[0] * cs2[0] + sgn * p1[0] * cs2[1]; v1[1] = v1[1] * cs2[2] + sgn * p1[1] * cs2[3];
                        v1[2] = v1[2] * cs3[0] + sgn * p1[2] * cs3[1]; v1[3] = v1[3] * cs3[2] + sgn * p1[3] * cs3[3];
                    }
                    u32x4 w; w.x = cvt_pk_bf16(v0[0], v0[1]); w.y = cvt_pk_bf16(v0[2], v0[3]); w.z = cvt_pk_bf16(v1[0], v1[1]); w.w = cvt_pk_bf16(v1[2], v1[3]);
                    *(u32x4*)(rowp + bj * 128) = w;
                    if (side) { float* sp = side + (size_t)row * kvw + scol + bj * 128; *(f32x4*)sp = v0; *(f32x4*)(sp + 4) = v1; }
                }
            }
    }
};
struct EpiBf {
    static constexpr bool PERM = true, AFTER_DRAIN = false;
    bf16_t* O; int ldc;
    __device__ __forceinline__ void operator()(const f32x4 (&acc)[2][2][4][2], const pg8::Unit& u, int wr, int wc, int fr, int fq) const {
        const int row0 = u.pm * 256 + wr * 64 + fr, col0 = u.pn * 256 + wc * 32 + 8 * fq;
#pragma unroll
        for (int ai = 0; ai < 2; ++ai)
#pragma unroll
            for (int m = 0; m < 4; ++m) { bf16_t* rowp = O + (size_t)(row0 + ai * 128 + m * 16) * ldc + col0;
#pragma unroll
                for (int bj = 0; bj < 2; ++bj) { const f32x4 v0 = acc[ai][bj][m][0], v1 = acc[ai][bj][m][1];
                    u32x4 w; w.x = cvt_pk_bf16(v0[0], v0[1]); w.y = cvt_pk_bf16(v0[2], v0[3]); w.z = cvt_pk_bf16(v1[0], v1[1]); w.w = cvt_pk_bf16(v1[2], v1[3]);
                    *(u32x4*)(rowp + bj * 128) = w; } }
    }
};
struct EpiResid {
    static constexpr bool PERM = false, AFTER_DRAIN = false;
    const float* xin_p; const float* xin_s; float* xout; const float* gate;
    __device__ __forceinline__ void operator()(const f32x4 (&acc)[2][2][4][2], const pg8::Unit& u, int wr, int wc, int fr, int fq) const {
        const int row0 = u.pm * 256 + wr * 64 + fr, col0 = u.pn * 256 + wc * 32 + 4 * fq;
        const float* gp = gate + (size_t)cond_of_row(u.pm * 256) * 12288 + col0;
        f32x4 gv[2][2];
#pragma unroll
        for (int bj = 0; bj < 2; ++bj)
#pragma unroll
            for (int n = 0; n < 2; ++n) gv[bj][n] = *(const f32x4*)(gp + bj * 128 + n * 16);
#pragma unroll
        for (int ai = 0; ai < 2; ++ai) { f32x4 xi[4][2][2];
#pragma unroll
            for (int m = 0; m < 4; ++m) { const int row = row0 + ai * 128 + m * 16;
                const float* ip = (row < NP ? xin_p + (size_t)row * D : xin_s + (size_t)(row - NP) * D) + col0;
#pragma unroll
                for (int bj = 0; bj < 2; ++bj)
#pragma unroll
                    for (int n = 0; n < 2; ++n) xi[m][bj][n] = *(const f32x4*)(ip + bj * 128 + n * 16); }
            asm volatile("" ::: "memory");
#pragma unroll
            for (int m = 0; m < 4; ++m) { const int row = row0 + ai * 128 + m * 16; float* op = xout + (size_t)row * D + col0;
#pragma unroll
                for (int bj = 0; bj < 2; ++bj)
#pragma unroll
                    for (int n = 0; n < 2; ++n) *(f32x4*)(op + bj * 128 + n * 16) = xi[m][bj][n] + gv[bj][n] * acc[ai][bj][m][n]; } }
    }
};

DI void tr_tile_wave(const float* src, bf16_t* dst, int K, int N, int k0, int n0, LAS float* ts, int lane) {
    const int ty = lane >> 4, tx = lane & 15;
    f32x4 v[16];
#pragma unroll
    for (int i = 0; i < 16; ++i) v[i] = *(const f32x4*)(src + (size_t)(k0 + ty + 4 * i) * N + n0 + 4 * tx);
#pragma unroll
    for (int i = 0; i < 16; ++i) { const int k = ty + 4 * i; ts[k * 65 + 4 * tx + 0] = v[i][0]; ts[k * 65 + 4 * tx + 1] = v[i][1]; ts[k * 65 + 4 * tx + 2] = v[i][2]; ts[k * 65 + 4 * tx + 3] = v[i][3]; }
    __builtin_amdgcn_fence(__ATOMIC_ACQ_REL, "wavefront"); __builtin_amdgcn_wave_barrier();
    const int nl = lane >> 3, kc = (lane & 7) * 8;
#pragma unroll
    for (int g = 0; g < 8; ++g) { const int n = 8 * g + nl; float w[8];
#pragma unroll
        for (int j = 0; j < 8; ++j) w[j] = ts[(kc + j) * 65 + n];
        u32x4 pk; pk.x = cvt_pk_bf16(w[0], w[1]); pk.y = cvt_pk_bf16(w[2], w[3]); pk.z = cvt_pk_bf16(w[4], w[5]); pk.w = cvt_pk_bf16(w[6], w[7]);
        *(u32x4*)(dst + (size_t)(n0 + n) * K + k0 + kc) = pk; }
    __builtin_amdgcn_fence(__ATOMIC_ACQ_REL, "wavefront"); __builtin_amdgcn_wave_barrier();
}
DI void cvt_range(const float* src, bf16_t* dst, size_t n8, size_t gtid, size_t gstride) {
    for (size_t i = gtid; i < n8; i += gstride) { const f32x4 a = *(const f32x4*)(src + i * 8), b = *(const f32x4*)(src + i * 8 + 4);
        u32x4 w; w.x = cvt_pk_bf16(a[0], a[1]); w.y = cvt_pk_bf16(a[2], a[3]); w.z = cvt_pk_bf16(b[0], b[1]); w.w = cvt_pk_bf16(b[2], b[3]); *(u32x4*)(dst + i * 8) = w; }
}
DI void mod_unit(const Params& p, int u, LAS float* sl) {
    const int tid = threadIdx.x, lane = tid & 63, wave = tid >> 6;
    const int l = u / 384, cb = (u % 384) * 32, cl = tid & 7, ks = tid >> 3;
    for (int i = tid; i < 9 * 2048; i += NTHR) { const int c = i >> 11, k = i & 2047; const float v = (c == 0) ? p.c_ctx[k] : p.c[(c - 1) * 2048 + k]; sl[i] = v / (1.f + __expf(-v)); }
    __syncthreads();
    const float* W = p.w_mod + (size_t)l * 2048 * 12288 + cb + 4 * cl;
    float acc[9][4];
#pragma unroll
    for (int c = 0; c < 9; ++c)
#pragma unroll
        for (int j = 0; j < 4; ++j) acc[c][j] = 0.f;
#pragma unroll 4
    for (int kk = 0; kk < 32; ++kk) { const int k = kk * 64 + ks; const f32x4 w = *(const f32x4*)(W + (size_t)k * 12288);
#pragma unroll
        for (int c = 0; c < 9; ++c) { const float s = sl[c * 2048 + k];
#pragma unroll
            for (int j = 0; j < 4; ++j) acc[c][j] += s * w[j]; } }
#pragma unroll
    for (int c = 0; c < 9; ++c)
#pragma unroll
        for (int j = 0; j < 4; ++j) { float v = acc[c][j]; v += __shfl_xor(v, 8); v += __shfl_xor(v, 16); v += __shfl_xor(v, 32); acc[c][j] = v; }
    __syncthreads();
    LAS float* red = sl;
    if (lane < 8) {
#pragma unroll
        for (int c = 0; c < 9; ++c)
#pragma unroll
            for (int j = 0; j < 4; ++j) red[(wave * 9 + c) * 32 + cl * 4 + j] = acc[c][j]; }
    __syncthreads();
    if (tid < 288) { const int c = tid >> 5, col = tid & 31; float s = 0.f;
#pragma unroll
        for (int w = 0; w < 8; ++w) s += red[(w * 9 + c) * 32 + col];
        float* mod = (float*)(p.ws + WS_MOD);
        mod[(size_t)(l * 9 + c) * 12288 + cb + col] = s + p.b_mod[(size_t)l * 12288 + cb + col]; }
    __syncthreads();
}
constexpr int TR_T0 = 2560, TR_T1 = TR_T0 + 1024, TR_T2 = TR_T1 + 3072, TR_T3 = TR_T2 + 1024, TR_T4 = TR_T3 + 1024, TR_T5 = TR_T4 + 1024, TR_T6 = TR_T5 + 128;
constexpr int PRO_UNITS = TR_T6 + 768;

DI void prologue_phase(const Params& p, LAS unsigned char* lds) {
    const int tid = threadIdx.x;
    unsigned char* ws = p.ws;
    if (blockIdx.x == 0) {
        float* rope = (float*)(ws + WS_ROPE);
        for (int i = tid; i < 1024; i += NTHR) { const int pos = i >> 4, f = i & 15; const float inv = powf(10000.f, -(float)f / 16.f); const float ang = (float)pos * inv; rope[2 * i] = cosf(ang); rope[2 * i + 1] = sinf(ang); }
        if (tid < 64) { const float* lp = p.a_lambda; float a = lp[tid] * lp[64 + tid], b = lp[128 + tid] * lp[192 + tid]; a = wave_sum(a); b = wave_sum(b);
            if (tid == 0) ((float*)(ws + WS_SCAL))[0] = expf(a) - expf(b) + 0.2f; }
    }
    { const int lane = tid & 63, wave = tid >> 6;
      for (int u = blockIdx.x * NWAVES + wave; u < TR_T6; u += gridDim.x * NWAVES) {
          const float* src; bf16_t* dst; int K = 2048, N, t;
          if (u < TR_T0) { src = p.even_w_in; dst = (bf16_t*)(ws + WS_WEI); N = EVEN_IN; t = u; }
          else if (u < TR_T1) { src = p.even_w_out; dst = (bf16_t*)(ws + WS_WEO); N = D; t = u - TR_T0; }
          else if (u < TR_T2) { src = p.odd_w_in; dst = (bf16_t*)(ws + WS_WOI); N = ODD_IN; t = u - TR_T1; }
          else if (u < TR_T3) { src = p.odd_w_out; dst = (bf16_t*)(ws + WS_WOO); N = D; t = u - TR_T2; }
          else if (u < TR_T4) { src = p.peer_w_q; dst = (bf16_t*)(ws + WS_WPQ); N = D; t = u - TR_T3; }
          else if (u < TR_T5) { src = p.peer_w_q + (size_t)D * D; dst = (bf16_t*)(ws + WS_WPQ) + (size_t)D * D; N = D; t = u - TR_T4; }
          else { t = u - TR_T5; const int mat = t >> 2; t &= 3; const int kind = mat >> 4, rest = mat & 15;
              src = (kind ? p.lru_w_i : p.lru_w_a) + (size_t)rest * 128 * 128; dst = (bf16_t*)(ws + WS_LRW) + (size_t)mat * 128 * 128; K = 128; N = 128; }
          const int ntn = N / 64; const int tk = t / ntn, tn = t % ntn;
          tr_tile_wave(src, dst, K, N, tk * 64, tn * 64, (LAS float*)lds + wave * (64 * 65), lane);
      } }
    __syncthreads();
    for (int u = blockIdx.x; u < PRO_UNITS - TR_T6; u += gridDim.x) mod_unit(p, u, (LAS float*)lds);
    const size_t gtid = (size_t)blockIdx.x * NTHR + tid, gstride = (size_t)gridDim.x * NTHR;
    cvt_range(p.peer_sub_keys, (bf16_t*)(ws + WS_SK), (size_t)2 * 8 * 2 * 128 * 128 / 8, gtid, gstride);
    cvt_range(p.cache_a_k, (bf16_t*)(ws + WS_CAK), (size_t)8 * 512 * 1024 / 8, gtid, gstride);
    cvt_range(p.cache_a_v, (bf16_t*)(ws + WS_CAV), (size_t)8 * 512 * 1024 / 8, gtid, gstride);
    cvt_range(p.cache_c_k, (bf16_t*)(ws + WS_CCK), (size_t)8 * 512 * 2048 / 8, gtid, gstride);
    cvt_range(p.cache_c_v, (bf16_t*)(ws + WS_CCV), (size_t)8 * 512 * 2048 / 8, gtid, gstride);
    { const int lane = tid & 63, wave = tid >> 6;
      bool interleaved;
      { f32x16 pa, pb;
#pragma unroll
        for (int i = 0; i < 16; ++i) { pa[i] = 0.125f * (float)i; pb[i] = i < 8 ? 2.f + 0.25f * (float)i : 4.f + 0.5f * (float)(i - 8); }
        const f32x32 d = __builtin_amdgcn_cvt_scalef32_pk32_f32_fp6(__builtin_amdgcn_cvt_scalef32_2xpk16_fp6_f32(pa, pb, 1.0f), 1.0f);
        interleaved = (d[1] != 0.125f); }
      for (int rw = blockIdx.x * NWAVES + wave; rw < 4 * PEER_N; rw += gridDim.x * NWAVES) {
          const int tbl = rw >> 15, r = rw & 32767;
          const float* src = (tbl ? p.peer_v : p.peer_u) + (size_t)r * D + 32 * lane;
          f32x4 x[8]; float am = 0.f;
#pragma unroll
          for (int q = 0; q < 8; ++q) { x[q] = *(const f32x4*)(src + 4 * q);
#pragma unroll
              for (int j = 0; j < 4; ++j) am = fmaxf(am, fabsf(x[q][j])); }
          am = fmaxf(am, __shfl_xor(am, 1)); am = fmaxf(am, __shfl_xor(am, 2)); am = fmaxf(am, __shfl_xor(am, 4)); am = fmaxf(am, __shfl_xor(am, 8)); am = fmaxf(am, __shfl_xor(am, 16)); am = fmaxf(am, __shfl_xor(am, 32));
          const float inv = am > 0.f ? 7.5f / am : 0.f;
          f32x16 a, b;
          if (!interleaved) {
#pragma unroll
              for (int i = 0; i < 16; ++i) { a[i] = x[i >> 2][i & 3] * inv; b[i] = x[4 + (i >> 2)][i & 3] * inv; }
          } else {
#pragma unroll
              for (int i = 0; i < 16; ++i) { a[i] = x[(2 * i) >> 2][(2 * i) & 3] * inv; b[i] = x[(2 * i + 1) >> 2][(2 * i + 1) & 3] * inv; }
          }
          const u32x6 pk = __builtin_amdgcn_cvt_scalef32_2xpk16_fp6_f32(a, b, 1.0f);
          unsigned char* dst = ws + (tbl ? WS_PV : WS_PU) + (size_t)r * PROW + 24 * lane;
          *(u32x2*)dst = (u32x2){pk[0], pk[1]}; *(u32x2*)(dst + 8) = (u32x2){pk[2], pk[3]}; *(u32x2*)(dst + 16) = (u32x2){pk[4], pk[5]};
          if (lane == 0) ((float*)(ws + (tbl ? WS_PSV : WS_PSU)))[r] = am > 0.f ? am * (1.f / 7.5f) : 1.f;
      } }
}

DI void norm_row_store(const f32x4 (&x)[4][2], const float* g, const float* shift, const float* scale, bf16_t* hrow, int lane) {
    float ss = 0.f;
#pragma unroll
    for (int k = 0; k < 4; ++k)
#pragma unroll
        for (int q = 0; q < 2; ++q)
#pragma unroll
            for (int j = 0; j < 4; ++j) ss += x[k][q][j] * x[k][q][j];
    ss = wave_sum(ss);
    const float rs = rsqrtf(ss * (1.f / 2048.f) + 1e-6f);
#pragma unroll
    for (int k = 0; k < 4; ++k) { const int e = 512 * k + 8 * lane; float y[8];
#pragma unroll
        for (int q = 0; q < 2; ++q) { const f32x4 gv = *(const f32x4*)(g + e + 4 * q), sc = *(const f32x4*)(scale + e + 4 * q), sh = *(const f32x4*)(shift + e + 4 * q);
#pragma unroll
            for (int j = 0; j < 4; ++j) y[4 * q + j] = x[k][q][j] * rs * gv[j] * (1.f + sc[j]) + sh[j]; }
        u32x4 w; w.x = cvt_pk_bf16(y[0], y[1]); w.y = cvt_pk_bf16(y[2], y[3]); w.z = cvt_pk_bf16(y[4], y[5]); w.w = cvt_pk_bf16(y[6], y[7]);
        *(u32x4*)(hrow + e) = w; }
}
template <bool FIRST> DI void norm_phase(const Params& p, int l, int which) {
    const int tid = threadIdx.x, lane = tid & 63, wave = tid >> 6;
    const float* mod = (const float*)(p.ws + WS_MOD) + (size_t)l * 9 * 12288;
    const float* g = (which ? p.norm2_g : p.norm1_g) + l * D;
    bf16_t* h = (bf16_t*)(p.ws + WS_H);
    const float* xres = p.out + OUT_YP;
    constexpr int RPW = NTOK / (256 * NWAVES);
    int cached = -1; f32x4 gs[4][2], sh[4][2];
    for (int gw = blockIdx.x * NWAVES + wave; gw * RPW < NTOK; gw += gridDim.x * NWAVES)
        for (int i = 0; i < RPW; ++i) { const int row = gw * RPW + i;
            const float* xr = FIRST ? (row < NP ? p.x_prompt + (size_t)row * D : p.x_sample + (size_t)(row - NP) * D) : xres + (size_t)row * D;
            f32x4 x[4][2];
#pragma unroll
            for (int k = 0; k < 4; ++k)
#pragma unroll
                for (int q = 0; q < 2; ++q) x[k][q] = *(const f32x4*)(xr + 512 * k + 8 * lane + 4 * q);
            const int cond = cond_of_row(row);
            if (cond != cached) { cached = cond; const float* mc = mod + (size_t)cond * 12288 + which * 3 * D;
#pragma unroll
                for (int k = 0; k < 4; ++k)
#pragma unroll
                    for (int q = 0; q < 2; ++q) { const int e = 512 * k + 8 * lane + 4 * q; const f32x4 gv = *(const f32x4*)(g + e), sc = *(const f32x4*)(mc + D + e); sh[k][q] = *(const f32x4*)(mc + e);
#pragma unroll
                        for (int j = 0; j < 4; ++j) gs[k][q][j] = gv[j] * (1.f + sc[j]); } }
            float ss = 0.f;
#pragma unroll
            for (int k = 0; k < 4; ++k)
#pragma unroll
                for (int q = 0; q < 2; ++q)
#pragma unroll
                    for (int j = 0; j < 4; ++j) ss += x[k][q][j] * x[k][q][j];
            ss = wave_sum(ss);
            const float rs = rsqrtf(ss * (1.f / 2048.f) + 1e-6f);
#pragma unroll
            for (int k = 0; k < 4; ++k) { float y[8];
#pragma unroll
                for (int q = 0; q < 2; ++q)
#pragma unroll
                    for (int j = 0; j < 4; ++j) y[4 * q + j] = x[k][q][j] * rs * gs[k][q][j] + sh[k][q][j];
                u32x4 w; w.x = cvt_pk_bf16(y[0], y[1]); w.y = cvt_pk_bf16(y[2], y[3]); w.z = cvt_pk_bf16(y[4], y[5]); w.w = cvt_pk_bf16(y[6], y[7]);
                *(u32x4*)(h + (size_t)row * D + 512 * k + 8 * lane) = w; }
        }
}

constexpr int KT_BYTES = 16384, VT_BYTES = 16384, ATT_BUF = KT_BYTES + VT_BYTES;
constexpr int ATT_RPB = 2 * ATT_BUF;
#define MFMA32(a, b, c) __builtin_amdgcn_mfma_f32_32x32x16_bf16((a), (b), (c), 0, 0, 0)
struct AttnArgs {
    const bf16_t* Q; int ldq;
    const bf16_t* K0; const bf16_t* V0; int n0, ld0;
    const bf16_t* K1; const bf16_t* V1; int n1, ld1;
    bf16_t* O; int ldo;
    float C;
    float lam; const float* subg;
    const float* rpb; int qr0, krlo;
};
DI void att_dma(const AttnArgs& a, int j, LAS unsigned char* buf, int wave, int lane) {
    int key0 = j * 64; const bf16_t* K = a.K0; const bf16_t* V = a.V0; int ld = a.ld0;
    if (key0 >= a.n0) { key0 -= a.n0; K = a.K1; V = a.V1; ld = a.ld1; }
    const int sub = lane >> 5, rr = (lane >> 2) & 7, cp = lane & 3;
#pragma unroll
    for (int i = 0; i < 2; ++i) { const int pc = 2 * wave + i, R = pc >> 1, Cp = pc & 1;
        const int row = 8 * R + rr, ch = 4 * (2 * Cp + sub) + (cp ^ ((2 * R + (rr >> 2)) & 3));
        const size_t off = (size_t)(key0 + row) * ld + ch * 8;
        __builtin_amdgcn_global_load_lds((const unsigned*)(K + off), (LAS unsigned*)(buf + pc * 1024), 16, 0, 0);
        __builtin_amdgcn_global_load_lds((const unsigned*)(V + off), (LAS unsigned*)(buf + KT_BYTES + pc * 1024), 16, 0, 0); }
}
DI bf16x8 pack8(const f32x16& x, int s) {
    u32x4 w; w.x = cvt_pk_bf16(x[8 * s + 0], x[8 * s + 1]); w.y = cvt_pk_bf16(x[8 * s + 2], x[8 * s + 3]); w.z = cvt_pk_bf16(x[8 * s + 4], x[8 * s + 5]); w.w = cvt_pk_bf16(x[8 * s + 6], x[8 * s + 7]);
    return __builtin_bit_cast(bf16x8, w);
}
template <int MODE> DI void attn_unit(LAS unsigned char* lds, const AttnArgs& a) {
    const int tid = threadIdx.x, lane = tid & 63, wave = __builtin_amdgcn_readfirstlane(tid >> 6), r = lane & 31, h = lane >> 5;
    constexpr int NKS = MODE == 0 ? 4 : 8;
    const int qloc = MODE == 0 ? 32 * (wave >> 1) + r : 32 * wave + r;
    const int kofs = MODE == 0 ? 64 * (wave & 1) : 0;
    bf16x8 qf[NKS];
    { const bf16_t* qp = a.Q + (size_t)qloc * a.ldq + kofs + 8 * h;
#pragma unroll
      for (int ks = 0; ks < NKS; ++ks) qf[ks] = *(const bf16x8*)(qp + 16 * ks); }
    if (MODE == 2) { for (int i = tid; i < 465; i += NTHR) ((LAS float*)(lds + ATT_RPB))[i] = a.rpb[i] * 1.4426950408889634f; }
    f32x16 o[4];
#pragma unroll
    for (int d4 = 0; d4 < 4; ++d4)
#pragma unroll
        for (int i = 0; i < 16; ++i) o[d4][i] = 0.f;
    float m = -1e30f, l = 0.f;
    const int ntiles = (a.n0 + a.n1) >> 6;
    att_dma(a, 0, lds, wave, lane);
    asm volatile("s_waitcnt vmcnt(0)" ::: "memory");
    __syncthreads();
    int qr = 0, qc = 0, cs = 0, rs = 0;
    if (MODE == 2) { qr = a.qr0 + (wave >> 1); qc = 32 * (wave & 1) + r; cs = min(max(qc - 8, 0), 48); rs = min(max(qr - 4, 0), 56); }
    const int kb0 = 2048 * (r >> 3) + 64 * (r & 7) + 512 * (kofs >> 5);
    const int kbase0 = kb0 + 16 * ((0 + h) ^ ((r >> 2) & 3)), kbase1 = kb0 + 16 * ((2 + h) ^ ((r >> 2) & 3));
    const int tblk = (lane >> 4) & 1, tq = (lane & 15) >> 2, tp = lane & 3;
    const int vb0 = 64 * (4 * h + tq) + 8 * (tp & 1);
    const int vbase0 = vb0 + 16 * ((2 * tblk + (tp >> 1)) ^ ((0 + h) & 3)), vbase1 = vb0 + 2048 + 16 * ((2 * tblk + (tp >> 1)) ^ ((2 + h) & 3));
    for (int j = 0; j < ntiles; ++j) {
        LAS unsigned char* buf = lds + (j & 1) * ATT_BUF;
        if (j + 1 < ntiles) att_dma(a, j + 1, lds + ((j + 1) & 1) * ATT_BUF, wave, lane);
        bool active = true; int kr = 0;
        if (MODE == 2 && j >= 8) { kr = a.krlo + (j - 8); const int wrs = min(max(a.qr0 + (wave >> 1) - 4, 0), 56); active = (kr >= wrs) && (kr < wrs + 8); }
        if (active) {
            f32x16 s0, s1;
#pragma unroll
            for (int i = 0; i < 16; ++i) { s0[i] = 0.f; s1[i] = 0.f; }
#pragma unroll
            for (int ks = 0; ks < NKS; ++ks) { const LAS unsigned char* kp = buf + ((ks & 1) ? kbase1 : kbase0) + 512 * (ks >> 1);
                const bf16x8 k0 = *(const LAS bf16x8*)kp, k1 = *(const LAS bf16x8*)(kp + 8192);
                s0 = MFMA32(k0, qf[ks], s0); s1 = MFMA32(k1, qf[ks], s1); }
            if (MODE == 2) {
#pragma unroll
                for (int i = 0; i < 16; ++i) { s0[i] *= a.C; s1[i] *= a.C; }
                if (j >= 8) {
                    const LAS float* rp = (const LAS float*)(lds + ATT_RPB) + (kr - qr + 7) * 31 + 15 - qc;
#pragma unroll
                    for (int i = 0; i < 16; ++i) { const int kc = (i & 3) + 8 * (i >> 2) + 4 * h;
                        s0[i] = (kc >= cs && kc < cs + 16) ? s0[i] + rp[kc] : -INFINITY;
                        s1[i] = (kc + 32 >= cs && kc + 32 < cs + 16) ? s1[i] + rp[kc + 32] : -INFINITY; }
                }
            }
            const float Ce = MODE == 2 ? 1.f : a.C;
            float mx = fmaxf(s0[0], s1[0]);
#pragma unroll
            for (int i = 1; i < 16; ++i) mx = fmaxf(mx, fmaxf(s0[i], s1[i]));
            mx = fmaxf(mx, __shfl_xor(mx, 32)) * Ce;
            if (!__all(mx <= m + 8.f)) {
                const float mn = fmaxf(m, mx), alpha = __builtin_amdgcn_exp2f(m - mn); m = mn; l *= alpha;
#pragma unroll
                for (int d4 = 0; d4 < 4; ++d4)
#pragma unroll
                    for (int i = 0; i < 16; ++i) o[d4][i] *= alpha;
            }
            float ps = 0.f;
#pragma unroll
            for (int i = 0; i < 16; ++i) { s0[i] = __builtin_amdgcn_exp2f(fmaf(s0[i], Ce, -m)); s1[i] = __builtin_amdgcn_exp2f(fmaf(s1[i], Ce, -m)); ps += s0[i] + s1[i]; }
            l += ps;
            bf16x8 pf[4]; pf[0] = pack8(s0, 0); pf[1] = pack8(s0, 1); pf[2] = pack8(s1, 0); pf[3] = pack8(s1, 1);
            const LAS unsigned char* vp0 = buf + KT_BYTES + vbase0; const LAS unsigned char* vp1 = buf + KT_BYTES + vbase1;
#pragma unroll
            for (int kk = 0; kk < 4; ++kk)
#pragma unroll
                for (int d4 = 0; d4 < 4; ++d4) {
                    const s16x4 lo = __builtin_amdgcn_ds_read_tr16_b64_v4i16((LAS s16x4*)(vp0 + 4096 * kk + 512 * d4));
                    const s16x4 hi = __builtin_amdgcn_ds_read_tr16_b64_v4i16((LAS s16x4*)(vp1 + 4096 * kk + 512 * d4));
                    bf16x8 vf; vf[0] = lo[0]; vf[1] = lo[1]; vf[2] = lo[2]; vf[3] = lo[3]; vf[4] = hi[0]; vf[5] = hi[1]; vf[6] = hi[2]; vf[7] = hi[3];
                    o[d4] = MFMA32(vf, pf[kk], o[d4]);
                }
        }
        asm volatile("s_waitcnt vmcnt(0)" ::: "memory");
        __syncthreads();
    }
    l += __shfl_xor(l, 32);
    const float inv = 1.f / l;
    if (MODE != 0) {
        bf16_t* op = a.O + (size_t)qloc * a.ldo + 4 * h;
#pragma unroll
        for (int d4 = 0; d4 < 4; ++d4)
#pragma unroll
            for (int g4 = 0; g4 < 4; ++g4) { u32x2 w; w.x = cvt_pk_bf16(o[d4][4 * g4] * inv, o[d4][4 * g4 + 1] * inv); w.y = cvt_pk_bf16(o[d4][4 * g4 + 2] * inv, o[d4][4 * g4 + 3] * inv);
                *(u32x2*)(op + 32 * d4 + 8 * g4) = w; }
    } else {
        LAS float* ex = (LAS float*)lds + qloc * 132 + 4 * h;
        if (wave & 1) {
#pragma unroll
            for (int d4 = 0; d4 < 4; ++d4)
#pragma unroll
                for (int g4 = 0; g4 < 4; ++g4) { f32x4 v; v[0] = o[d4][4 * g4] * inv; v[1] = o[d4][4 * g4 + 1] * inv; v[2] = o[d4][4 * g4 + 2] * inv; v[3] = o[d4][4 * g4 + 3] * inv; *(LAS f32x4*)(ex + 32 * d4 + 8 * g4) = v; }
        }
        __syncthreads();
        if (!(wave & 1)) {
            float ss = 0.f;
#pragma unroll
            for (int d4 = 0; d4 < 4; ++d4)
#pragma unroll
                for (int g4 = 0; g4 < 4; ++g4) { const f32x4 o1 = *(const LAS f32x4*)(ex + 32 * d4 + 8 * g4);
#pragma unroll
                    for (int e = 0; e < 4; ++e) { const float v = o[d4][4 * g4 + e] * inv - a.lam * o1[e]; o[d4][4 * g4 + e] = v; ss += v * v; } }
            ss += __shfl_xor(ss, 32);
            const float rsn = rsqrtf(ss * (1.f / 128.f) + 1e-6f) * 0.8f;
            bf16_t* op = a.O + (size_t)qloc * a.ldo + 4 * h;
#pragma unroll
            for (int d4 = 0; d4 < 4; ++d4)
#pragma unroll
                for (int g4 = 0; g4 < 4; ++g4) { const f32x4 gv = *(const f32x4*)(a.subg + 32 * d4 + 8 * g4 + 4 * h);
                    u32x2 w; w.x = cvt_pk_bf16(o[d4][4 * g4] * rsn * gv[0], o[d4][4 * g4 + 1] * rsn * gv[1]); w.y = cvt_pk_bf16(o[d4][4 * g4 + 2] * rsn * gv[2], o[d4][4 * g4 + 3] * rsn * gv[3]);
                    *(u32x2*)(op + 32 * d4 + 8 * g4) = w; }
        }
        __syncthreads();
    }
}
DI int q_next(unsigned* ctr, volatile LAS unsigned* misc) {
    __syncthreads();
    if (threadIdx.x == 0) misc[0] = __hip_atomic_fetch_add(ctr, 1u, __ATOMIC_RELAXED, __HIP_MEMORY_SCOPE_AGENT);
    __syncthreads();
    return (int)misc[0];
}

constexpr int LR_W = 0;
constexpr int LR_WK = 128 * 272;
constexpr int LR_XR = LR_W + 2 * LR_WK;
constexpr int LR_XCB = LR_XR + 9216;
constexpr int LR_XC = LR_XCB + 32 * 272;
constexpr int LR_AS = LR_XC + 32 * 132 * 4;
constexpr int LR_BS = LR_AS + 32 * 144 * 4;
constexpr int LR_CAR = LR_BS + 32 * 144 * 4;
constexpr int LR_HC = LR_CAR + 4 * 128 * 8;
constexpr int LR_END = LR_HC + 512;
static_assert(LR_END <= LDS_MISC, "LRU LDS map");
#define MFMA16(a, b, c) __builtin_amdgcn_mfma_f32_16x16x32_bf16((a), (b), (c), 0, 0, 0)

DI float fast_sigmoid(float x) { return __builtin_amdgcn_rcpf(1.f + __builtin_amdgcn_exp2f(-1.4426950408889634f * x)); }
DI void lru_unit(const Params& p, LAS unsigned char* lds, int seq, int blk) {
    const int tid = threadIdx.x, lane = tid & 63, wave = __builtin_amdgcn_readfirstlane(tid >> 6);
    const int T = seq < 32 ? TP : TS, tb = seq < 32 ? seq * TP : NP + (seq - 32) * TS, c0 = blk * 128;
    const bf16_t* proj = (const bf16_t*)(p.ws + WS_PROJ);
    float* HF = (float*)(p.ws + WS_H);
    bf16_t* mix = (bf16_t*)(p.ws + WS_MIX);
    const bf16_t* lrw = (const bf16_t*)(p.ws + WS_LRW);
    const int c = tid & 127, sub = tid >> 7;
    float cw[4];
#pragma unroll
    for (int j = 0; j < 4; ++j) cw[j] = p.lru_conv_w[j * 1024 + c0 + c];
    const float cb = p.lru_conv_b[c0 + c];
    const int tbk = wave & 1, cg = wave >> 1, fr = lane & 15, fq = lane >> 4;
    LAS float* HC = (LAS float*)(lds + LR_HC);
    for (int dir = 0; dir < 2; ++dir) {
        __syncthreads();
#pragma unroll
        for (int i = 0; i < 8; ++i) { const int ch = tid + 512 * i, kind = ch >> 11, rem = ch & 2047, o = rem >> 4, cc = rem & 15;
            const u32x4 w = *(const u32x4*)(lrw + ((size_t)((kind * 2 + dir) * 8 + blk) * 128 + o) * 128 + cc * 8);
            *(LAS u32x4*)(lds + LR_W + kind * LR_WK + o * 272 + cc * 16) = w; }
        float ba[2], bi[2], nsp[2];
#pragma unroll
        for (int cbk = 0; cbk < 2; ++cbk) { const int o = c0 + 32 * cg + 16 * cbk + fr; ba[cbk] = p.lru_b_a[dir * 1024 + o]; bi[cbk] = p.lru_b_i[dir * 1024 + o];
            const float lam = p.lru_lambda[dir * 1024 + o]; const float sp = (-lam > 20.f) ? -lam : log1pf(__expf(-lam)); nsp[cbk] = -8.f * sp * 1.4426950408889634f; }
        if (tid < 128) HC[tid] = (seq >= 32) ? p.state_lru[(size_t)(seq - 32) * 2048 + dir * 1024 + c0 + tid] : 0.f;
        const int nch = T / 32;
        u32x4 xrn[2];
        auto ld_xr = [&](int t0) {
#pragma unroll
            for (int i = 0; i < 2; ++i) { const int ch = tid + 512 * i, row = ch >> 4, cc = ch & 15, t = t0 - 2 + row; u32x4 v = {0u, 0u, 0u, 0u};
                if (ch < 560 && t >= 0 && t < T) v = *(const u32x4*)(proj + (size_t)(tb + t) * EVEN_IN + 3072 + c0 + cc * 8);
                xrn[i] = v; } };
        ld_xr(dir ? T - 32 : 0);
        for (int chk = 0; chk < nch; ++chk) {
            const int t0 = dir ? T - 32 - 32 * chk : 32 * chk;
#pragma unroll
            for (int i = 0; i < 2; ++i) { const int ch = tid + 512 * i; if (ch < 560) *(LAS u32x4*)(lds + LR_XR + ch * 16) = xrn[i]; }
            if (chk + 1 < nch) ld_xr(dir ? t0 - 32 : t0 + 32);
            float hfv[8]; unsigned short gv[8];
            if (dir) {
#pragma unroll
                for (int i = 0; i < 8; ++i) { const int tl = 31 - (8 * sub + i); const size_t tok = (size_t)(tb + t0 + tl);
                    hfv[i] = HF[tok * 1024 + c0 + c]; gv[i] = proj[tok * EVEN_IN + 4096 + c0 + c]; } }
            __syncthreads();
            { const LAS bf16_t* xr = (const LAS bf16_t*)(lds + LR_XR);
#pragma unroll
              for (int i = 0; i < 8; ++i) { const int tl = 8 * sub + i; float acc = cb;
#pragma unroll
                  for (int j = 0; j < 4; ++j) acc += cw[j] * __uint_as_float(((unsigned)xr[(tl + j) * 128 + c]) << 16);
                  ((LAS float*)(lds + LR_XC))[tl * 132 + c] = acc;
                  ((LAS bf16_t*)(lds + LR_XCB))[tl * 136 + c] = (bf16_t)(cvt_pk_bf16(acc, 0.f) & 0xffffu); } }
            __syncthreads();
            { f32x4 acc[2][2];
#pragma unroll
              for (int k = 0; k < 2; ++k)
#pragma unroll
                  for (int cbk = 0; cbk < 2; ++cbk) acc[k][cbk] = (f32x4){0.f, 0.f, 0.f, 0.f};
#pragma unroll
              for (int ks = 0; ks < 4; ++ks) { const bf16x8 af = *(const LAS bf16x8*)(lds + LR_XCB + (16 * tbk + fr) * 272 + (32 * ks + 8 * fq) * 2);
#pragma unroll
                  for (int k = 0; k < 2; ++k)
#pragma unroll
                      for (int cbk = 0; cbk < 2; ++cbk) { const bf16x8 bf = *(const LAS bf16x8*)(lds + LR_W + k * LR_WK + (32 * cg + 16 * cbk + fr) * 272 + (32 * ks + 8 * fq) * 2);
                          acc[k][cbk] = MFMA16(af, bf, acc[k][cbk]); } }
#pragma unroll
              for (int cbk = 0; cbk < 2; ++cbk)
#pragma unroll
                  for (int rg = 0; rg < 4; ++rg) { const int tl = 16 * tbk + 4 * fq + rg, o = 32 * cg + 16 * cbk + fr;
                      const float rr = fast_sigmoid(acc[0][cbk][rg] + ba[cbk]), ii = fast_sigmoid(acc[1][cbk][rg] + bi[cbk]);
                      const float la = rr * nsp[cbk], av = __builtin_amdgcn_exp2f(la), xc = ((const LAS float*)(lds + LR_XC))[tl * 132 + o];
                      const float bv = __builtin_amdgcn_sqrtf(fmaxf((1.f - av) * (1.f + av), 0.f)) * ii * xc;
                      ((LAS float*)(lds + LR_AS))[tl * 144 + o] = av; ((LAS float*)(lds + LR_BS))[tl * 144 + o] = bv; } }
            __syncthreads();
            float hl[8], Pv[8];
            { float hh = 0.f, P = 1.f;
#pragma unroll
              for (int i = 0; i < 8; ++i) { const int u = 8 * sub + i, tl = dir ? 31 - u : u; const float av = ((const LAS float*)(lds + LR_AS))[tl * 144 + c], bv = ((const LAS float*)(lds + LR_BS))[tl * 144 + c];
                  hh = av * hh + bv; P *= av; hl[i] = hh; Pv[i] = P; }
              *(LAS f32x2*)(lds + LR_CAR + (sub * 128 + c) * 8) = (f32x2){P, hh}; }
            __syncthreads();
            float hin = HC[c];
#pragma unroll
            for (int s = 0; s < 3; ++s) if (s < sub) { const f32x2 e = *(const LAS f32x2*)(lds + LR_CAR + (s * 128 + c) * 8); hin = e[0] * hin + e[1]; }
            float hv[8];
#pragma unroll
            for (int i = 0; i < 8; ++i) hv[i] = hl[i] + Pv[i] * hin;
            __syncthreads();
            if (sub == 3) HC[c] = hv[7];
            if (!dir) {
#pragma unroll
                for (int i = 0; i < 8; ++i) { const int tl = 8 * sub + i; HF[(size_t)(tb + t0 + tl) * 1024 + c0 + c] = hv[i]; }
            } else {
#pragma unroll
                for (int i = 0; i < 8; ++i) { const int tl = 31 - (8 * sub + i); const float g = __uint_as_float(((unsigned)gv[i]) << 16);
                    const float ov = (hfv[i] + hv[i]) * gelu_tanh(g);
                    mix[(size_t)(tb + t0 + tl) * D + 1024 + c0 + c] = (bf16_t)(cvt_pk_bf16(ov, 0.f) & 0xffffu); }
            }
        }
        __syncthreads();
        if (seq < 32 && tid < 128) p.out[OUT_LRU + (size_t)seq * 2048 + dir * 1024 + c0 + tid] = HC[tid];
    }
    __syncthreads();
}

constexpr int PS_ROW = 129;
#define PS_WAVE_SYNC() do { __builtin_amdgcn_fence(__ATOMIC_ACQ_REL, "wavefront"); __builtin_amdgcn_wave_barrier(); } while (0)
#define PS_INSERT(tv, v) do { _Pragma("unroll") for (int _i = 15; _i >= 1; --_i) tv[_i] = __builtin_amdgcn_fmed3f(tv[_i - 1], tv[_i], (v)); tv[0] = fmaxf(tv[0], (v)); } while (0)
DI void peer_select_phase(const Params& p, int l, LAS unsigned char* lds) {
    const int tid = threadIdx.x, lane = tid & 63, wave = __builtin_amdgcn_readfirstlane(tid >> 6), fr = lane & 15, fq = lane >> 4;
    const bf16_t* qp = (const bf16_t*)(p.ws + WS_MIX);
    const bf16_t* skl = (const bf16_t*)(p.ws + WS_SK) + (size_t)l * 8 * 2 * 128 * 128;
    int* pidx = (int*)(p.ws + WS_PIDX); float* pgate = (float*)(p.ws + WS_PGATE);
    LAS float* SCw = (LAS float*)lds + wave * (32 * PS_ROW);
    for (int u = blockIdx.x; u < 1280; u += gridDim.x) {
        const int head = u / 160, tile = u % 160, tw = tile * 256 + 32 * wave;
        float alist[16], blist[16];
#pragma unroll
        for (int pp = 0; pp < 2; ++pp) {
            f32x4 acc[2][8];
#pragma unroll
            for (int g = 0; g < 2; ++g)
#pragma unroll
                for (int kb = 0; kb < 8; ++kb) acc[g][kb] = (f32x4){0.f, 0.f, 0.f, 0.f};
            const bf16_t* qrow = qp + (size_t)(tw + fr) * D + head * 256 + pp * 128 + 8 * fq;
            const bf16_t* kbase = skl + ((size_t)(head * 2 + pp) * 128 + fr) * 128 + 8 * fq;
#pragma unroll
            for (int ks = 0; ks < 4; ++ks) { const bf16x8 af0 = *(const bf16x8*)(qrow + 32 * ks), af1 = *(const bf16x8*)(qrow + (size_t)16 * D + 32 * ks);
#pragma unroll
                for (int kb = 0; kb < 8; ++kb) { const bf16x8 bf = *(const bf16x8*)(kbase + (size_t)(16 * kb) * 128 + 32 * ks); acc[0][kb] = MFMA16(af0, bf, acc[0][kb]); acc[1][kb] = MFMA16(af1, bf, acc[1][kb]); } }
#pragma unroll
            for (int g = 0; g < 2; ++g)
#pragma unroll
                for (int kb = 0; kb < 8; ++kb)
#pragma unroll
                    for (int rg = 0; rg < 4; ++rg) SCw[(16 * g + 4 * fq + rg) * PS_ROW + 16 * kb + fr] = acc[g][kb][rg];
            PS_WAVE_SYNC();
            { LAS float* sp = SCw + (lane >> 1) * PS_ROW + 64 * (lane & 1);
              float tv[16];
#pragma unroll
              for (int i = 0; i < 16; ++i) tv[i] = -INFINITY;
#pragma unroll 4
              for (int k = 0; k < 64; ++k) { const float v = __uint_as_float((__float_as_uint(sp[k]) & ~127u) | (unsigned)(64 * (lane & 1) + k)); PS_INSERT(tv, v); }
#pragma unroll
              for (int i = 0; i < 16; ++i) sp[i] = tv[i]; }
            PS_WAVE_SYNC();
            if (lane < 32) { const LAS float* sp = SCw + lane * PS_ROW; float tv[16], ob[16];
#pragma unroll
                for (int i = 0; i < 16; ++i) { tv[i] = sp[i]; ob[i] = sp[64 + i]; }
#pragma unroll
                for (int i = 0; i < 16; ++i) PS_INSERT(tv, ob[i]);
#pragma unroll
                for (int i = 0; i < 16; ++i) { if (pp == 0) alist[i] = tv[i]; else blist[i] = tv[i]; } }
            PS_WAVE_SYNC();
        }
        if (lane < 32) {
            LAS float* pa = SCw + lane * PS_ROW; LAS float* pb = pa + 64;
#pragma unroll
            for (int i = 0; i < 16; ++i) { pa[i] = alist[i]; pb[i] = blist[i]; }
            float tv[16];
#pragma unroll
            for (int i = 0; i < 16; ++i) tv[i] = -INFINITY;
#pragma unroll
            for (int i = 0; i < 16; ++i)
#pragma unroll
                for (int j = 0; j < 16; ++j) if ((i + 1) * (j + 1) <= 16) { const float cvv = __uint_as_float((__float_as_uint(alist[i] + blist[j]) & ~255u) | (unsigned)(i * 16 + j)); PS_INSERT(tv, cvv); }
            float bs[16]; int bidx[16];
#pragma unroll
            for (int k = 0; k < 16; ++k) { const unsigned code = __float_as_uint(tv[k]) & 255u; const int i1 = (int)(__float_as_uint(pa[code >> 4]) & 127u), i2 = (int)(__float_as_uint(pb[code & 15u]) & 127u);
                bidx[k] = i1 * 128 + i2; bs[k] = tv[k]; }
            float den = 0.f; const float bmax = bs[0];
#pragma unroll
            for (int k = 0; k < 16; ++k) { bs[k] = __expf(bs[k] - bmax); den += bs[k]; }
            const float inv = 1.f / den;
            const size_t ob = (size_t)(tw + lane) * 128 + head * 16;
#pragma unroll
            for (int k4 = 0; k4 < 4; ++k4) { *(int4*)(pidx + ob + 4 * k4) = make_int4(bidx[4 * k4], bidx[4 * k4 + 1], bidx[4 * k4 + 2], bidx[4 * k4 + 3]);
                *(f32x4*)(pgate + ob + 4 * k4) = (f32x4){bs[4 * k4] * inv, bs[4 * k4 + 1] * inv, bs[4 * k4 + 2] * inv, bs[4 * k4 + 3] * inv}; }
        }
        PS_WAVE_SYNC();
    }
}

#define PG_ISSUE(UB, VB, e) do { const int _id = __builtin_amdgcn_readlane(((e) < 64) ? idA : idB, (e) & 63); unsigned _lo = loff; asm("" : "+v"(_lo));   \
    const unsigned char* _u = U6 + (size_t)_id * PROW; const unsigned char* _v = V6 + (size_t)_id * PROW; \
    UB[0] = *(const u32x2*)(_u + _lo); UB[1] = *(const u32x2*)(_u + _lo + 8); UB[2] = *(const u32x2*)(_u + _lo + 16); VB[0] = *(const u32x2*)(_v + _lo); VB[1] = *(const u32x2*)(_v + _lo + 8); VB[2] = *(const u32x2*)(_v + _lo + 16); } while (0)
#define PG_LANEF(A, B, e) __int_as_float(__builtin_amdgcn_readlane(__float_as_int(((e) < 64) ? A : B), (e) & 63))
#define PG_DEC(B) __builtin_amdgcn_cvt_scalef32_pk32_f32_fp6((u32x6){B[0].x, B[0].y, B[1].x, B[1].y, B[2].x, B[2].y}, 1.0f)
#define PG_COMPUTE(UB, VB, e) do { float _d0 = 0.f, _d1 = 0.f; { const f32x32 _ud = PG_DEC(UB); \
    _Pragma("unroll") for (int _i = 0; _i < 32; _i += 2) { _d0 += xf[_i] * _ud[_i]; _d1 += xf[_i + 1] * _ud[_i + 1]; } } \
    const float _d = wave_sum_dpp(_d0 + _d1) * PG_LANEF(suA, suB, e); const float _a = gelu_tanh(_d) * PG_LANEF(gsA, gsB, e); \
    { const f32x32 _vd = PG_DEC(VB); _Pragma("unroll") for (int _i = 0; _i < 32; ++_i) o[_i] += _a * _vd[_i]; } } while (0)
DI void wave_sum_dpp2(float a, float b, float& ra, float& rb) {
    a += dpp_get<0xB1, 0xf>(a); b += dpp_get<0xB1, 0xf>(b); a += dpp_get<0x4E, 0xf>(a); b += dpp_get<0x4E, 0xf>(b);
    a += dpp_get<0x141, 0xf>(a); b += dpp_get<0x141, 0xf>(b); a += dpp_get<0x140, 0xf>(a); b += dpp_get<0x140, 0xf>(b);
    a += dpp_get<0x142, 0xa>(a); b += dpp_get<0x142, 0xa>(b); a += dpp_get<0x143, 0xc>(a); b += dpp_get<0x143, 0xc>(b);
    ra = __int_as_float(__builtin_amdgcn_readlane(__float_as_int(a), 63)); rb = __int_as_float(__builtin_amdgcn_readlane(__float_as_int(b), 63));
}
#define PG_DECH(B) __builtin_bit_cast(H16, __builtin_amdgcn_cvt_scalef32_pk32_f16_fp6((u32x6){B[0].x, B[0].y, B[1].x, B[1].y, B[2].x, B[2].y}, 1.0f))
#define PG_DECB(B) __builtin_bit_cast(u32x16, __builtin_amdgcn_cvt_scalef32_pk32_bf16_fp6((u32x6){B[0].x, B[0].y, B[1].x, B[1].y, B[2].x, B[2].y}, 1.0f))
#define PG_COMPUTE2(UA, VA, UB, VB, e) do { float _a0 = 0.f, _a1 = 0.f, _b0 = 0.f, _b1 = 0.f; { const u32x16 _ua = PG_DECB(UA); const u32x16 _ub = PG_DECB(UB); \
    _Pragma("unroll") for (int _i = 0; _i < 16; _i += 2) { asm("v_dot2c_f32_bf16 %0, %1, %2" : "+v"(_a0) : "v"(xp[_i]), "v"(_ua[_i])); asm("v_dot2c_f32_bf16 %0, %1, %2" : "+v"(_b0) : "v"(xp[_i]), "v"(_ub[_i])); \
        asm("v_dot2c_f32_bf16 %0, %1, %2" : "+v"(_a1) : "v"(xp[_i + 1]), "v"(_ua[_i + 1])); asm("v_dot2c_f32_bf16 %0, %1, %2" : "+v"(_b1) : "v"(xp[_i + 1]), "v"(_ub[_i + 1])); } } \
    float _da, _db; wave_sum_dpp2(_a0 + _a1, _b0 + _b1, _da, _db); _da *= PG_LANEF(suA, suB, e); _db *= PG_LANEF(suA, suB, (e) + 1); \
    const float _ga = gelu_tanh(_da) * PG_LANEF(gsA, gsB, e), _gb = gelu_tanh(_db) * PG_LANEF(gsA, gsB, (e) + 1); \
    { const H16 _vd = PG_DECH(VA); const _Float16 _h = (_Float16)(_ga * 256.f); const h2 _g2 = {_h, _h}; _Pragma("unroll") for (int _i = 0; _i < 16; ++_i) o2[_i] = _g2 * _vd.v[_i] + o2[_i]; } \
    { const H16 _vd = PG_DECH(VB); const _Float16 _h = (_Float16)(_gb * 256.f); const h2 _g2 = {_h, _h}; _Pragma("unroll") for (int _i = 0; _i < 16; ++_i) o2[_i] = _g2 * _vd.v[_i] + o2[_i]; } } while (0)
DI void peer_gather_phase(const Params& p, int l, bool last, LAS unsigned char* lds) {
    const int tid = threadIdx.x, lane = tid & 63, wave = __builtin_amdgcn_readfirstlane(tid >> 6); const unsigned loff = 24u * (unsigned)lane;
    const unsigned char* U6 = p.ws + WS_PU + (size_t)l * PEER_N * PROW;
    const unsigned char* V6 = p.ws + WS_PV + (size_t)l * PEER_N * PROW;
    const float* su = (const float*)(p.ws + WS_PSU) + l * PEER_N; const float* sv = (const float*)(p.ws + WS_PSV) + l * PEER_N;
    const int* pidx = (const int*)(p.ws + WS_PIDX); const float* pgate = (const float*)(p.ws + WS_PGATE);
    bf16_t* hbuf = (bf16_t*)(p.ws + WS_H);
    float* xres = p.out + OUT_YP;
    const float* mod = (const float*)(p.ws + WS_MOD);
    for (int tok = blockIdx.x * NWAVES + wave; tok < NTOK; tok += gridDim.x * NWAVES) {
        int ln = lane; asm volatile("" : "+v"(ln));
        unsigned xp[16];
#pragma unroll
        for (int q = 0; q < 4; ++q) { const u32x4 a = *(const u32x4*)(hbuf + (size_t)tok * D + 32 * ln + 8 * q); xp[4 * q] = a.x; xp[4 * q + 1] = a.y; xp[4 * q + 2] = a.z; xp[4 * q + 3] = a.w; }
        int idA = pidx[(size_t)tok * 128 + ln], idB = pidx[(size_t)tok * 128 + 64 + ln];
        float gA = pgate[(size_t)tok * 128 + ln], gB = pgate[(size_t)tok * 128 + 64 + ln];
        { int rA = 0, rB = 0;
          for (int j = 0; j < 64; ++j) { const int ja = __builtin_amdgcn_readlane(idA, j), jb = __builtin_amdgcn_readlane(idB, j);
              rA += (ja < idA || (ja == idA && j < lane)) ? 1 : 0; rA += (jb < idA) ? 1 : 0;
              rB += (ja <= idB) ? 1 : 0; rB += (jb < idB || (jb == idB && j < lane)) ? 1 : 0; }
          LAS int* sid = (LAS int*)(lds + wave * 1024); LAS float* sg = (LAS float*)(lds + wave * 1024 + 512);
          sid[rA] = idA; sg[rA] = gA; sid[rB] = idB; sg[rB] = gB;
          idA = sid[lane]; gA = sg[lane]; idB = sid[64 + lane]; gB = sg[64 + lane]; }
        const float suA = su[idA], suB = su[idB], gsA = gA * sv[idA], gsB = gB * sv[idB];
        h2 o2[16];
#pragma unroll
        for (int j = 0; j < 16; ++j) o2[j] = (h2){(_Float16)0.f, (_Float16)0.f};
        u32x2 u0[3], v0[3], u1[3], v1[3], u2[3], v2[3], u3[3], v3[3], u4[3], v4[3], u5[3], v5[3];
        PG_ISSUE(u0, v0, 0); PG_ISSUE(u1, v1, 1); PG_ISSUE(u2, v2, 2); PG_ISSUE(u3, v3, 3);
        for (int e = 0; e < 120; e += 6) {
            PG_ISSUE(u4, v4, e + 4); PG_ISSUE(u5, v5, e + 5); PG_COMPUTE2(u0, v0, u1, v1, e);
            PG_ISSUE(u0, v0, e + 6); PG_ISSUE(u1, v1, e + 7); PG_COMPUTE2(u2, v2, u3, v3, e + 2);
            PG_ISSUE(u2, v2, e + 8); PG_ISSUE(u3, v3, e + 9); PG_COMPUTE2(u4, v4, u5, v5, e + 4);
        }
        PG_ISSUE(u4, v4, 124); PG_ISSUE(u5, v5, 125); PG_COMPUTE2(u0, v0, u1, v1, 120);
        PG_ISSUE(u0, v0, 126); PG_ISSUE(u1, v1, 127); PG_COMPUTE2(u2, v2, u3, v3, 122);
        PG_COMPUTE2(u4, v4, u5, v5, 124);
        PG_COMPUTE2(u0, v0, u1, v1, 126);
        float o[32];
        { LAS float* tr = (LAS float*)(lds + 8192) + wave * (64 * 33);
#pragma unroll
          for (int j = 0; j < 16; ++j) { tr[33 * ln + 2 * j] = (float)o2[j].x * (1.f / 256.f); tr[33 * ln + 2 * j + 1] = (float)o2[j].y * (1.f / 256.f); }
          PS_WAVE_SYNC();
#pragma unroll
          for (int q = 0; q < 8; ++q)
#pragma unroll
              for (int j = 0; j < 4; ++j) o[4 * q + j] = tr[33 * (8 * q + (ln >> 3)) + 4 * (ln & 7) + j];
          PS_WAVE_SYNC(); }
        const float* mc = mod + (size_t)(l * 9 + cond_of_row(tok)) * 12288;
        f32x4 xn[8]; float ss = 0.f;
#pragma unroll
        for (int q = 0; q < 8; ++q) { const int eo = 256 * q + 4 * ln; const f32x4 xv = *(const f32x4*)(xres + (size_t)tok * D + eo), gt = *(const f32x4*)(mc + 5 * D + eo);
#pragma unroll
            for (int j = 0; j < 4; ++j) { xn[q][j] = xv[j] + gt[j] * o[4 * q + j]; ss += xn[q][j] * xn[q][j]; } }
        ss = wave_sum(ss);
        const float rs = rsqrtf(ss * (1.f / 2048.f) + 1e-6f);
        if (!last) {
            const float* mn = mod + (size_t)((l + 1) * 9 + cond_of_row(tok)) * 12288; const float* g = p.norm1_g + (l + 1) * D;
            u32x2 w[8];
#pragma unroll
            for (int q = 0; q < 8; ++q) { const int eo = 256 * q + 4 * ln;
                const f32x4 gv = *(const f32x4*)(g + eo), sh = *(const f32x4*)(mn + eo), sc = *(const f32x4*)(mn + D + eo); float y[4];
#pragma unroll
                for (int j = 0; j < 4; ++j) y[j] = xn[q][j] * rs * gv[j] * (1.f + sc[j]) + sh[j];
                w[q].x = cvt_pk_bf16(y[0], y[1]); w[q].y = cvt_pk_bf16(y[2], y[3]); }
            asm volatile("" ::: "memory");
#pragma unroll
            for (int q = 0; q < 8; ++q) *(f32x4*)(xres + (size_t)tok * D + 256 * q + 4 * ln) = xn[q];
#pragma unroll
            for (int q = 0; q < 8; ++q) *(u32x2*)(hbuf + (size_t)tok * D + 256 * q + 4 * ln) = w[q];
        } else {
            f32x4 y[8];
#pragma unroll
            for (int q = 0; q < 8; ++q) { const int eo = 256 * q + 4 * ln; const f32x4 gv = *(const f32x4*)(p.final_norm_g + eo);
#pragma unroll
                for (int j = 0; j < 4; ++j) y[q][j] = xn[q][j] * rs * gv[j]; }
            asm volatile("" ::: "memory");
#pragma unroll
            for (int q = 0; q < 8; ++q) *(f32x4*)(xres + (size_t)tok * D + 256 * q + 4 * ln) = y[q];
        }
    }
}

constexpr int N_PHASES = 16;
#ifndef MK_SPLIT
#define MK_SPLIT 0
#endif

__global__ void __launch_bounds__(NTHR, 2) mk_fwd(Params p) {
    extern __shared__ __attribute__((aligned(16))) unsigned char lds_raw[];
    LAS unsigned char* lds = (LAS unsigned char*)lds_raw;
    const int tid = threadIdx.x;
    volatile LAS unsigned* misc = (volatile LAS unsigned*)(lds + LDS_MISC);
    if (tid < 64) misc[tid] = 0u;
    __syncthreads();
    unsigned char* ws = p.ws;
    XcdBarrier bar; bar.bar = (unsigned*)(ws + WS_BAR); bar.x = 0; bar.st = nullptr;
    const bool fused = (p.ph_hi - p.ph_lo) > 1;
    if (fused) bar = xcd_barrier_post((unsigned*)(ws + WS_BAR), misc + 8);
#define PH(k) (p.ph_lo <= (k) && (k) < p.ph_hi)
#define SEAM(k) do { if (p.ph_lo <= (k) && (k) + 1 < p.ph_hi) xcd_barrier(bar); } while (0)
    float* mod = (float*)(ws + WS_MOD);
    bf16_t* hbuf = (bf16_t*)(ws + WS_H);
    bf16_t* proj = (bf16_t*)(ws + WS_PROJ);
    bf16_t* mix = (bf16_t*)(ws + WS_MIX);
    float* xres = p.out + OUT_YP;

    if (PH(0)) prologue_phase(p, lds);
    SEAM(0);
    if (PH(1)) norm_phase<true>(p, 0, 0);
    SEAM(1);
    if (PH(2)) {
        pg8::Gemm g; g.A = hbuf; g.Bt = (const bf16_t*)(ws + WS_WEI); g.M = NTOK; g.N = EVEN_IN; g.K = D;
        pg8::StaticOrder S; S.init(g.M, g.N, (int)gridDim.x, (int)blockIdx.x);
        EpiProj E; E.O = proj; E.ldc = EVEN_IN; E.outK = p.out + OUT_AK; E.outV = p.out + OUT_AV; E.kstart = 1024; E.vstart = 2048; E.kvw = 1024; E.rope = (const float*)(ws + WS_ROPE);
        pg8::gemm_phase<EpiProj, pg8::StaticOrder, false>(lds, g, S, E, nullptr);
    }
    SEAM(2);
    if (PH(3)) {
        unsigned* ctrL = (unsigned*)(ws + WS_CTR); unsigned* ctrA = ctrL + 64;
        for (;;) {
            const int u = q_next(ctrL, misc);
            if (u >= 320) break;
            const int seq = u < 64 ? 32 + (u >> 3) : ((u - 64) >> 3), blk = u & 7;
            lru_unit(p, lds, seq, blk);
        }
        const bf16_t* cak = (const bf16_t*)(ws + WS_CAK); const bf16_t* cav = (const bf16_t*)(ws + WS_CAV);
        const float lam = ((const float*)(ws + WS_SCAL))[0];
        for (;;) {
            const int u = q_next(ctrA, misc);
            if (u >= 2560) break;
            AttnArgs a; a.C = 0.125f * 1.4426950408889634f; a.lam = lam; a.subg = p.a_subln_g; a.rpb = nullptr; a.qr0 = 0; a.krlo = 0; a.ldq = EVEN_IN; a.ldo = D; a.ld1 = EVEN_IN;
            if (u < 2048) { const int b = u >> 8, head = (u & 255) >> 5, qb = u & 31; const size_t tb = NP + (size_t)b * TS;
                a.Q = proj + (tb + 128 * qb) * EVEN_IN + head * 128;
                a.K0 = cak + (size_t)b * PAST * 1024 + head * 128; a.V0 = cav + (size_t)b * PAST * 1024 + head * 128; a.n0 = PAST; a.ld0 = 1024;
                a.K1 = proj + tb * EVEN_IN + 1024 + head * 128; a.V1 = proj + tb * EVEN_IN + 2048 + head * 128; a.n1 = TS;
                a.O = mix + (tb + 128 * qb) * D + head * 128;
            } else { const int i = u - 2048, b = i >> 4, head = (i & 15) >> 1, half = i & 1; const size_t tb = (size_t)b * TP;
                a.Q = proj + (tb + 128 * half) * EVEN_IN + head * 128;
                a.K0 = proj + tb * EVEN_IN + 1024 + head * 128; a.V0 = proj + tb * EVEN_IN + 2048 + head * 128; a.n0 = TP; a.ld0 = EVEN_IN;
                a.K1 = a.K0; a.V1 = a.V0; a.n1 = 0;
                a.O = mix + (tb + 128 * half) * D + head * 128;
            }
            attn_unit<0>(lds, a);
        }
    }
    SEAM(3);
    if (PH(4)) {
        pg8::Gemm g; g.A = mix; g.Bt = (const bf16_t*)(ws + WS_WEO); g.M = NTOK; g.N = D; g.K = D;
        pg8::StaticOrder S; S.init(g.M, g.N, (int)gridDim.x, (int)blockIdx.x);
        EpiResid E; E.xin_p = p.x_prompt; E.xin_s = p.x_sample; E.xout = xres; E.gate = mod + 2 * D;
        pg8::gemm_phase<EpiResid, pg8::StaticOrder, false>(lds, g, S, E, nullptr);
    }
    SEAM(4);
    if (PH(5)) norm_phase<false>(p, 0, 1);
    SEAM(5);
    if (PH(6)) {
        pg8::Gemm g; g.A = hbuf; g.Bt = (const bf16_t*)(ws + WS_WPQ); g.M = NTOK; g.N = D; g.K = D;
        pg8::StaticOrder S; S.init(g.M, g.N, (int)gridDim.x, (int)blockIdx.x);
        EpiBf E; E.O = mix; E.ldc = D;
        pg8::gemm_phase<EpiBf, pg8::StaticOrder, false>(lds, g, S, E, nullptr);
    }
    SEAM(6);
    if (PH(7)) peer_select_phase(p, 0, lds);
    SEAM(7);
    if (PH(8)) peer_gather_phase(p, 0, false, lds);
    SEAM(8);
    if (PH(9)) {
        pg8::Gemm g; g.A = hbuf; g.Bt = (const bf16_t*)(ws + WS_WOI); g.M = NTOK; g.N = ODD_IN; g.K = D;
        pg8::StaticOrder S; S.init(g.M, g.N, (int)gridDim.x, (int)blockIdx.x);
        EpiProj E; E.O = proj; E.ldc = ODD_IN; E.outK = p.out + OUT_CK; E.outV = p.out + OUT_CV; E.kstart = 2048; E.vstart = 4096; E.kvw = 2048; E.rope = nullptr;
        pg8::gemm_phase<EpiProj, pg8::StaticOrder, false>(lds, g, S, E, nullptr);
    }
    SEAM(9);
    if (PH(10)) {
        unsigned* ctrN = (unsigned*)(ws + WS_CTR) + 128; unsigned* ctrD = ctrN + 64;
        const bf16_t* cck = (const bf16_t*)(ws + WS_CCK); const bf16_t* ccv = (const bf16_t*)(ws + WS_CCV);
        for (;;) {
            const int u = q_next(ctrN, misc);
            if (u >= 2048) break;
            AttnArgs a; a.C = 0.08838834764831845f * 1.4426950408889634f; a.lam = 0.f; a.subg = nullptr; a.ldq = ODD_IN; a.ldo = D;
            const int b = u >> 8, head = (u & 255) >> 4, rb = u & 15; const size_t tb = NP + (size_t)b * TS;
            const int krlo = min(max(4 * rb - 4, 0), 56), krhi = min(max(4 * rb - 1, 0), 56) + 7;
            a.Q = proj + (tb + 256 * rb) * ODD_IN + head * 128;
            a.K0 = cck + (size_t)b * PAST * 2048 + head * 128; a.V0 = ccv + (size_t)b * PAST * 2048 + head * 128; a.n0 = PAST; a.ld0 = 2048;
            a.K1 = proj + (tb + 64 * krlo) * ODD_IN + 2048 + head * 128; a.V1 = proj + (tb + 64 * krlo) * ODD_IN + 4096 + head * 128; a.n1 = (krhi - krlo + 1) * 64; a.ld1 = ODD_IN;
            a.O = mix + (tb + 256 * rb) * D + head * 128; a.rpb = p.na_rpb + head * 465; a.qr0 = 4 * rb; a.krlo = krlo;
            attn_unit<2>(lds, a);
        }
        for (;;) {
            const int u = q_next(ctrD, misc);
            if (u >= 512) break;
            AttnArgs a; a.C = 0.08838834764831845f * 1.4426950408889634f; a.lam = 0.f; a.subg = nullptr; a.ldq = ODD_IN; a.ldo = D;
            const int b = u >> 4, head = u & 15; const size_t tb = (size_t)b * TP;
            a.Q = proj + tb * ODD_IN + head * 128;
            a.K0 = proj + tb * ODD_IN + 2048 + head * 128; a.V0 = proj + tb * ODD_IN + 4096 + head * 128; a.n0 = TP; a.ld0 = ODD_IN;
            a.K1 = a.K0; a.V1 = a.V0; a.n1 = 0; a.ld1 = ODD_IN;
            a.O = mix + tb * D + head * 128; a.rpb = nullptr; a.qr0 = 0; a.krlo = 0;
            attn_unit<1>(lds, a);
        }
    }
    SEAM(10);
    if (PH(11)) {
        pg8::Gemm g; g.A = mix; g.Bt = (const bf16_t*)(ws + WS_WOO); g.M = NTOK; g.N = D; g.K = D;
        pg8::StaticOrder S; S.init(g.M, g.N, (int)gridDim.x, (int)blockIdx.x);
        EpiResid E; E.xin_p = xres; E.xin_s = xres + (size_t)NP * D; E.xout = xres; E.gate = mod + (size_t)9 * 12288 + 2 * D;
        pg8::gemm_phase<EpiResid, pg8::StaticOrder, false>(lds, g, S, E, nullptr);
    }
    SEAM(11);
    if (PH(12)) norm_phase<false>(p, 1, 1);
    SEAM(12);
    if (PH(13)) {
        pg8::Gemm g; g.A = hbuf; g.Bt = (const bf16_t*)(ws + WS_WPQ) + (size_t)D * D; g.M = NTOK; g.N = D; g.K = D;
        pg8::StaticOrder S; S.init(g.M, g.N, (int)gridDim.x, (int)blockIdx.x);
        EpiBf E; E.O = mix; E.ldc = D;
        pg8::gemm_phase<EpiBf, pg8::StaticOrder, false>(lds, g, S, E, nullptr);
    }
    SEAM(13);
    if (PH(14)) peer_select_phase(p, 1, lds);
    SEAM(14);
    if (PH(15)) peer_gather_phase(p, 1, true, lds);

#undef PH
#undef SEAM
}

extern "C" void kernel_launch(void* const* d_in, const int* in_sizes, int n_in, void* d_out, int out_size, void* d_ws, size_t ws_size, hipStream_t stream) {
    static int grid = 0;
    if (grid == 0) {
        if (n_in != 32 || ws_size < WS_END || (size_t)out_size != OUT_END) { fprintf(stderr, "kernel_launch: unexpected shapes: n_in %d out %d ws %zu (need %zu)\n", n_in, out_size, ws_size, (size_t)WS_END); grid = -1; return; }
        int dev = 0, cus = 0, per_cu = 0;
        if (hipGetDevice(&dev) != hipSuccess || hipDeviceGetAttribute(&cus, hipDeviceAttributeMultiprocessorCount, dev) != hipSuccess) { grid = -1; return; }
        if (hipFuncSetAttribute((const void*)mk_fwd, hipFuncAttributeMaxDynamicSharedMemorySize, LDS_BYTES) != hipSuccess) { fprintf(stderr, "kernel_launch: hipFuncSetAttribute failed\n"); grid = -1; return; }
        if (hipOccupancyMaxActiveBlocksPerMultiprocessor(&per_cu, (const void*)mk_fwd, NTHR, LDS_BYTES) != hipSuccess || per_cu < 1) { fprintf(stderr, "kernel_launch: occupancy query says %d\n", per_cu); }
        (void)hipGetLastError();
        grid = cus;
    }
    if (grid < 0) return;
    (void)hipMemsetAsync((char*)d_ws + WS_BAR, 0, WS_ZERO_BYTES, stream);
    Params p{};
    const float** pp = (const float**)&p;
    for (int i = 0; i < 32; ++i) pp[i] = (const float*)d_in[i];
    p.out = (float*)d_out; p.ws = (unsigned char*)d_ws;
#if MK_SPLIT
    for (int k = 0; k < N_PHASES; ++k) { p.ph_lo = k; p.ph_hi = k + 1; hipLaunchKernelGGL(mk_fwd, dim3(grid), dim3(NTHR), LDS_BYTES, stream, p); }
#else
    p.ph_lo = 0; p.ph_hi = N_PHASES;
    hipLaunchKernelGGL(mk_fwd, dim3(grid), dim3(NTHR), LDS_BYTES, stream, p);
#endif
    const hipError_t le = hipPeekAtLastError();
    if (le != hipSuccess) fprintf(stderr, "kernel_launch: launch failed: %s\n", hipGetErrorName(le));
}
```
